# Optimizing an MI355X kernel written in HIP

```python
import jax
import jax.numpy as jnp
from jax import lax
import numpy as np

D_MODEL = 2048
BATCH = 1
SEQ = 8192
DEPTH = 2

GRID_W = 64
CTX_LEN = 256
EPS = 1e-6
N_MOD = 6
MLA_HEADS = 8
QK_NOPE = 128
QK_ROPE = 64
V_HEAD = 128
Q_LORA = 512
KV_LORA = 256
ROPE_THETA = 10000.0
AXIS_ROPE = QK_ROPE // 2
Q_BLOCK = 128
CONV_CH = D_MODEL // 2
GLA_HEADS = 4
GLA_DK = D_MODEL // 2 // GLA_HEADS
GLA_DV = D_MODEL // GLA_HEADS
GLA_KEY = GLA_HEADS * GLA_DK
GLA_VAL = GLA_HEADS * GLA_DV
GATE_RANK = 16
GATE_NORMALIZER = 16.0
CHUNK = 64
D_FF = 5632
AB_CTX_COLS = KV_LORA + QK_ROPE
AB_SPLITS = (KV_LORA, AB_CTX_COLS, AB_CTX_COLS + Q_LORA, AB_CTX_COLS + Q_LORA + CONV_CH, AB_CTX_COLS + Q_LORA + 2 * CONV_CH)
AB_COLS = AB_CTX_COLS + Q_LORA + 3 * CONV_CH
AB_OUT = CONV_CH + MLA_HEADS * V_HEAD
GLA_CTX_COLS = GLA_KEY + GLA_VAL + 2 * GATE_RANK
GLA_SPLITS = (GLA_KEY, GLA_KEY + GLA_VAL, GLA_KEY + GLA_VAL + GATE_RANK, GLA_CTX_COLS, GLA_CTX_COLS + GLA_KEY)
GLA_COLS = GLA_CTX_COLS + GLA_KEY + GLA_VAL

kernel_name = 'hybrid_shortconv_mla_gla_convffn_dit'


def rmsnorm(x, w):
    xf = x.astype(jnp.float32)
    y = xf * lax.rsqrt(jnp.mean(xf * xf, axis=-1, keepdims=True) + EPS)
    return (y * w.astype(jnp.float32)).astype(x.dtype)


def modulate(x, w, shift, scale):
    return rmsnorm(x, w) * (1.0 + scale) + shift


def dwconv3(x, w, b=None):
    xp = jnp.pad(x, ((0, 0), (1, 1), (0, 0)))
    y = xp[:, :-2] * w[0] + xp[:, 1:-1] * w[1] + xp[:, 2:] * w[2]
    return y if b is None else y + b


def axial_rope_tables(n_tokens):
    rows = n_tokens // GRID_W
    row = jnp.repeat(jnp.arange(rows, dtype=jnp.float32), GRID_W)
    col = jnp.tile(jnp.arange(GRID_W, dtype=jnp.float32), rows)
    inv = ROPE_THETA ** (-jnp.arange(0, AXIS_ROPE, 2, dtype=jnp.float32) / AXIS_ROPE)
    ar = row[:, None] * inv
    ac = col[:, None] * inv
    ang = jnp.concatenate([ar, ar, ac, ac], axis=-1)
    return jnp.cos(ang), jnp.sin(ang)


def apply_rope(x, cos, sin):
    extra = x.ndim - 3
    cos = cos.reshape(cos.shape[0], *([1] * extra), cos.shape[1])
    sin = sin.reshape(sin.shape[0], *([1] * extra), sin.shape[1])
    xf = x.astype(jnp.float32)
    a1, a2, b1, b2 = jnp.split(xf, 4, axis=-1)
    rot = jnp.concatenate([-a2, a1, -b2, b1], axis=-1)
    return (xf * cos + rot * sin).astype(x.dtype)


def attention(q, k, v):
    s = jnp.einsum('bqhd,bkhd->bhqk', q, k, preferred_element_type=jnp.float32) * (q.shape[-1] ** -0.5)
    p = jax.nn.softmax(s, axis=-1).astype(v.dtype)
    return jnp.einsum('bhqk,bkhd->bqhd', p, v)


def blocked_attention(q, k, v):
    bsz, t, nh, dk = q.shape
    nb = t // Q_BLOCK
    qb = q.reshape(bsz, nb, Q_BLOCK, nh, dk).transpose(1, 0, 2, 3, 4)
    o = lax.map(lambda qi: attention(qi, k, v), qb)
    return o.transpose(1, 0, 2, 3, 4).reshape(bsz, t, nh, v.shape[-1])


def mla_q(q_lat, q_norm, w_qb, cos_sin):
    q = (rmsnorm(q_lat, q_norm) @ w_qb).reshape(q_lat.shape[0], q_lat.shape[1], MLA_HEADS, QK_NOPE + QK_ROPE)
    if cos_sin is None:
        return q
    return jnp.concatenate([q[..., :QK_NOPE], apply_rope(q[..., QK_NOPE:], *cos_sin)], axis=-1)


def mla_kv(kv_lat, k_rope, kv_norm, w_kvb, cos_sin):
    kv = (rmsnorm(kv_lat, kv_norm) @ w_kvb).reshape(kv_lat.shape[0], kv_lat.shape[1], MLA_HEADS, QK_NOPE + V_HEAD)
    if cos_sin is not None:
        k_rope = apply_rope(k_rope, *cos_sin)
    k_rope = jnp.broadcast_to(k_rope[:, :, None, :], kv.shape[:3] + (QK_ROPE,))
    k = jnp.concatenate([kv[..., :QK_NOPE], k_rope], axis=-1)
    return k, kv[..., QK_NOPE:]


def mixer_ab(h, hc, w_in, conv_a, q_norm, w_qb, kv_norm, w_kvb, w_out, ctx_out):
    bsz, t, _ = h.shape
    cos_sin = axial_rope_tables(t)
    z = h @ w_in
    zc = hc @ (w_in if ctx_out else w_in[:, :AB_CTX_COLS])
    kv_lat, k_rope, q_lat, a_x, a_b, a_c = jnp.split(z, list(AB_SPLITS), axis=-1)
    k_l, v_l = mla_kv(kv_lat, k_rope, kv_norm, w_kvb, cos_sin)
    k_c, v_c = mla_kv(zc[..., :KV_LORA], zc[..., KV_LORA:AB_CTX_COLS], kv_norm, w_kvb, None)
    q_l = mla_q(q_lat, q_norm, w_qb, cos_sin)
    o_l = blocked_attention(q_l, jnp.concatenate([k_l, k_c], axis=1), jnp.concatenate([v_l, v_c], axis=1))
    y_a = a_b * dwconv3(a_c * a_x, conv_a)
    y = jnp.concatenate([y_a, o_l.reshape(bsz, t, MLA_HEADS * V_HEAD)], axis=-1) @ w_out
    if not ctx_out:
        return y, None
    _, _, qc_lat, c_x, c_b, c_c = jnp.split(zc, list(AB_SPLITS), axis=-1)
    o_c = attention(mla_q(qc_lat, q_norm, w_qb, None), k_c, v_c)
    yc_a = c_b * dwconv3(c_c * c_x, conv_a)
    yc = jnp.concatenate([yc_a, o_c.reshape(o_c.shape[0], o_c.shape[1], MLA_HEADS * V_HEAD)], axis=-1) @ w_out
    return y, yc


def gla_chunked(q, k, v, g, h0):
    bsz, nh, t, dk = k.shape
    n = t // CHUNK
    with_q = q is not None

    def chunks(a):
        return a.reshape(bsz, nh, n, CHUNK, a.shape[-1]).transpose(2, 0, 1, 3, 4)

    mask = jnp.tril(jnp.ones((CHUNK, CHUNK), dtype=bool))

    def step(state, xs):
        if with_q:
            qc, kc, vc, gc = xs
        else:
            kc, vc, gc = xs
        b = jnp.cumsum(gc, axis=-2)
        b_last = b[..., -1:, :]
        new_state = state * jnp.swapaxes(jnp.exp(b_last), -1, -2) + jnp.einsum('bhcd,bhcv->bhdv', kc * jnp.exp(b_last - b), vc)
        if not with_q:
            return new_state, None
        qe = qc * jnp.exp(b)
        ke = kc * jnp.exp(-b)
        att = jnp.where(mask, jnp.einsum('bhid,bhjd->bhij', qe, ke), 0.0)
        out = jnp.einsum('bhij,bhjv->bhiv', att, vc) + jnp.einsum('bhid,bhdv->bhiv', qe, state)
        return new_state, out

    xs = (chunks(k), chunks(v), chunks(g))
    if with_q:
        xs = (chunks(q),) + xs
    final, out = lax.scan(step, h0, xs)
    if with_q:
        out = out.transpose(1, 2, 0, 3, 4).reshape(bsz, nh, t, v.shape[-1])
    return out, final


def to_heads(a, d):
    bsz, t, _ = a.shape
    return a.reshape(bsz, t, GLA_HEADS, d).transpose(0, 2, 1, 3).astype(jnp.float32)


def gla_gate(lr, w, b):
    return jax.nn.log_sigmoid((lr @ w + b).astype(jnp.float32)) / GATE_NORMALIZER


def rev(a):
    return a[:, :, ::-1]


def gla_prep(z, with_q, gfw_w, gfw_b, gbw_w, gbw_b):
    parts = jnp.split(z, list(GLA_SPLITS if with_q else GLA_SPLITS[:3]), axis=-1)
    k = to_heads(parts[0], GLA_DK)
    v = to_heads(parts[1], GLA_DV)
    g_fw = to_heads(gla_gate(parts[2], gfw_w, gfw_b), GLA_DK)
    g_bw = to_heads(gla_gate(parts[3], gbw_w, gbw_b), GLA_DK)
    if not with_q:
        return None, k, v, g_fw, g_bw, None
    q = to_heads(parts[4], GLA_DK) * (GLA_DK ** -0.5)
    return q, k, v, g_fw, g_bw, parts[5]


def gla_out(o, og, o_norm, w_out):
    bsz, nh, t, _ = o.shape
    o = rmsnorm(o, o_norm).transpose(0, 2, 1, 3).reshape(bsz, t, GLA_VAL).astype(og.dtype)
    return (o * jax.nn.silu(og)) @ w_out


def mixer_gla(h, hc, w_in, gfw_w, gfw_b, gbw_w, gbw_b, o_norm, w_out, ctx_out):
    bsz = h.shape[0]
    h0 = jnp.zeros((bsz, GLA_HEADS, GLA_DK, GLA_DV), jnp.float32)
    zc = hc @ (w_in if ctx_out else w_in[:, :GLA_CTX_COLS])
    qc, kc, vc, gfc, gbc, ogc = gla_prep(zc, ctx_out, gfw_w, gfw_b, gbw_w, gbw_b)
    oc_f, sc_f = gla_chunked(qc, kc, vc, gfc, h0)
    oc_b, sc_b = gla_chunked(rev(qc) if ctx_out else None, rev(kc), rev(vc), rev(gbc), h0)
    q, k, v, gf, gb, og = gla_prep(h @ w_in, True, gfw_w, gfw_b, gbw_w, gbw_b)
    o_f, _ = gla_chunked(q, k, v, gf, sc_f)
    o_b, _ = gla_chunked(rev(q), rev(k), rev(v), rev(gb), sc_b)
    y = gla_out(o_f + rev(o_b), og, o_norm, w_out)
    if not ctx_out:
        return y, None
    return y, gla_out(oc_f + rev(oc_b), ogc, o_norm, w_out)


def conv_ffn(h, w_up, conv_w, conv_b, w_down):
    u = dwconv3(h @ w_up, conv_w, conv_b)
    gate, val = jnp.split(u, 2, axis=-1)
    return (jax.nn.silu(gate) * val) @ w_down


def block(x, xc, c_act, cc_act, ada_w, ada_b, norm1, norm2, mixer_fn, mix, ffn, ctx_out):
    m = jnp.split((c_act @ ada_w + ada_b)[:, None, :], N_MOD, axis=-1)
    mc = jnp.split((cc_act @ ada_w + ada_b)[:, None, :], N_MOD, axis=-1)
    y, yc = mixer_fn(modulate(x, norm1, m[0], m[1]), modulate(xc, norm1, mc[0], mc[1]), *mix, ctx_out)
    x = x + m[2] * y
    x = x + m[5] * conv_ffn(modulate(x, norm2, m[3], m[4]), *ffn)
    if not ctx_out:
        return x, None
    xc = xc + mc[2] * yc
    xc = xc + mc[5] * conv_ffn(modulate(xc, norm2, mc[3], mc[4]), *ffn)
    return x, xc


def setup_inputs(seed: int = 0) -> dict:
    key = jax.random.key(seed)
    keys = iter(jax.random.split(key, 16 + 24 * DEPTH))

    def rnd(shape, scale):
        return jax.random.normal(next(keys), shape, jnp.float32) * scale

    def gain(n):
        return 1.0 + rnd((n,), 0.02)

    inp = {}
    inp['x'] = rnd((BATCH, SEQ, D_MODEL), 1.0)
    inp['c'] = rnd((BATCH, D_MODEL), 1.0)
    inp['ctx'] = rnd((BATCH, CTX_LEN, D_MODEL), 1.0)
    inp['c_ctx'] = rnd((D_MODEL,), 1.0)
    for i in range(DEPTH):
        p = 'l%d_' % i
        inp[p + 'ada_w'] = rnd((D_MODEL, N_MOD * D_MODEL), 0.5 * D_MODEL ** -0.5)
        inp[p + 'ada_b'] = rnd((N_MOD * D_MODEL,), 0.02)
        inp[p + 'norm1'] = gain(D_MODEL)
        if i % 2 == 0:
            inp[p + 'w_in'] = rnd((D_MODEL, AB_COLS), D_MODEL ** -0.5)
            inp[p + 'conv_a'] = rnd((3, CONV_CH), 3 ** -0.5)
            inp[p + 'q_norm'] = gain(Q_LORA)
            inp[p + 'w_qb'] = rnd((Q_LORA, MLA_HEADS * (QK_NOPE + QK_ROPE)), Q_LORA ** -0.5)
            inp[p + 'kv_norm'] = gain(KV_LORA)
            inp[p + 'w_kvb'] = rnd((KV_LORA, MLA_HEADS * (QK_NOPE + V_HEAD)), KV_LORA ** -0.5)
            inp[p + 'w_out'] = rnd((AB_OUT, D_MODEL), AB_OUT ** -0.5)
        else:
            inp[p + 'w_in'] = rnd((D_MODEL, GLA_COLS), D_MODEL ** -0.5)
            inp[p + 'gate_fw_w'] = rnd((GATE_RANK, GLA_KEY), GATE_RANK ** -0.5)
            inp[p + 'gate_fw_b'] = rnd((GLA_KEY,), 0.02)
            inp[p + 'gate_bw_w'] = rnd((GATE_RANK, GLA_KEY), GATE_RANK ** -0.5)
            inp[p + 'gate_bw_b'] = rnd((GLA_KEY,), 0.02)
            inp[p + 'o_norm'] = gain(GLA_DV)
            inp[p + 'w_out'] = rnd((GLA_VAL, D_MODEL), GLA_VAL ** -0.5)
        inp[p + 'norm2'] = gain(D_MODEL)
        inp[p + 'ffn_up'] = rnd((D_MODEL, 2 * D_FF), D_MODEL ** -0.5)
        inp[p + 'ffn_conv_w'] = rnd((3, 2 * D_FF), 3 ** -0.5)
        inp[p + 'ffn_conv_b'] = rnd((2 * D_FF,), 0.02)
        inp[p + 'ffn_down'] = rnd((D_FF, D_MODEL), D_FF ** -0.5)
    inp['final_norm'] = gain(D_MODEL)
    return inp


def reference(x, c, ctx, c_ctx,
              l0_ada_w, l0_ada_b, l0_norm1, l0_w_in, l0_conv_a, l0_q_norm, l0_w_qb, l0_kv_norm, l0_w_kvb, l0_w_out,
              l0_norm2, l0_ffn_up, l0_ffn_conv_w, l0_ffn_conv_b, l0_ffn_down,
              l1_ada_w, l1_ada_b, l1_norm1, l1_w_in, l1_gate_fw_w, l1_gate_fw_b, l1_gate_bw_w, l1_gate_bw_b, l1_o_norm, l1_w_out,
              l1_norm2, l1_ffn_up, l1_ffn_conv_w, l1_ffn_conv_b, l1_ffn_down,
              final_norm):
    layers = (
        (l0_ada_w, l0_ada_b, l0_norm1, l0_norm2,
         (l0_w_in, l0_conv_a, l0_q_norm, l0_w_qb, l0_kv_norm, l0_w_kvb, l0_w_out),
         (l0_ffn_up, l0_ffn_conv_w, l0_ffn_conv_b, l0_ffn_down)),
        (l1_ada_w, l1_ada_b, l1_norm1, l1_norm2,
         (l1_w_in, l1_gate_fw_w, l1_gate_fw_b, l1_gate_bw_w, l1_gate_bw_b, l1_o_norm, l1_w_out),
         (l1_ffn_up, l1_ffn_conv_w, l1_ffn_conv_b, l1_ffn_down)),
    )
    c_act = jax.nn.silu(c)
    cc_act = jax.nn.silu(c_ctx)[None, :]
    xc = ctx
    for i in range(DEPTH):
        ada_w, ada_b, n1, n2, mix, ffn = layers[i]
        mixer_fn = mixer_ab if i % 2 == 0 else mixer_gla
        x, xc = block(x, xc, c_act, cc_act, ada_w, ada_b, n1, n2, mixer_fn, mix, ffn, i < DEPTH - 1)
    return rmsnorm(x, final_norm)
```

```cpp
#include <hip/hip_runtime.h>
#include <hip/hip_cooperative_groups.h>
#include <cstdio>
#include <cstdint>
namespace cg = cooperative_groups;

#define LAS __attribute__((address_space(3)))
typedef unsigned short bf16_t;
typedef short bf16x8 __attribute__((ext_vector_type(8)));
typedef short s16x4 __attribute__((ext_vector_type(4)));
typedef float f32x4 __attribute__((ext_vector_type(4)));
typedef float f32x2 __attribute__((ext_vector_type(2)));
typedef float f32x16 __attribute__((ext_vector_type(16)));
typedef unsigned u32x4 __attribute__((ext_vector_type(4)));
typedef unsigned u32x2 __attribute__((ext_vector_type(2)));

#define REP_MASK 0u
#define BAR_REP 1
#define G1REP 1
#define P6REP 1
#define GREP 1
#ifndef N_LAUNCH_MODE
#define N_LAUNCH_MODE 1
#endif

constexpr int DM = 2048, SEQ = 8192, CTX = 256, NTOK = SEQ + CTX;
constexpr int NMOD = 6 * DM;
constexpr int ABN = 4096;
constexpr int GLN = 6400;
constexpr int DFF = 5632, DFF2 = 11264;
constexpr int NCH = 33;
constexpr int NPHASE = 24;

constexpr size_t MiB = 1u << 20;
constexpr size_t WS_CNT = 64 * 1024;
constexpr size_t WS_SLOT = 2 * MiB;
constexpr size_t WS_MOD = 1 * MiB;
constexpr size_t WS_DEC = 1 * MiB + 512 * 1024;
constexpr size_t WS_W0IN = 4 * MiB, WS_W0QB = 20 * MiB, WS_W0KVB = 21 * MiB + 512 * 1024, WS_W0OUT = 22 * MiB + 512 * 1024,
                 WS_W0UP = 30 * MiB + 512 * 1024, WS_W0DN = 74 * MiB + 512 * 1024;
constexpr size_t WS_KVT = 4 * MiB;
constexpr size_t WS_W1OUT = 96 * MiB + 512 * 1024, WS_W1UP = 104 * MiB + 512 * 1024, WS_W1DN = 148 * MiB + 512 * 1024;
constexpr size_t WS_XN = 171 * MiB;
constexpr size_t WS_KDT = WS_XN;
constexpr size_t WS_XR = 204 * MiB;
constexpr size_t WS_Z0 = 270 * MiB, WS_KVN = 336 * MiB, WS_QN = 341 * MiB, WS_KR = 350 * MiB, WS_Q = 352 * MiB, WS_KV = 377 * MiB, WS_OA = 410 * MiB;
constexpr size_t WS_U = 270 * MiB, WS_H = 452 * MiB;
constexpr size_t WS_Z1 = 270 * MiB, WS_AQ = 374 * MiB, WS_OG = 374 * MiB, WS_KE = 422 * MiB, WS_O = 422 * MiB, WS_BT4 = 454 * MiB, WS_W1IN = 553 * MiB;
constexpr size_t WS_PART = 578 * MiB;
constexpr size_t WS_AT = 578 * MiB;
constexpr size_t WS_END = 610 * MiB;

__device__ __forceinline__ float bf2f(unsigned v) { return __uint_as_float(v << 16); }
__device__ __forceinline__ unsigned f2bf(float f) { unsigned u = __float_as_uint(f); return (u + 0x7fffu + ((u >> 16) & 1u)) >> 16; }
__device__ __forceinline__ unsigned pk2(float lo, float hi) { return f2bf(lo) | (f2bf(hi) << 16); }
__device__ __forceinline__ unsigned cvt_pk_bf16(float lo, float hi) { unsigned r; asm volatile("v_cvt_pk_bf16_f32 %0, %1, %2" : "=v"(r) : "v"(lo), "v"(hi)); return r; }
__device__ __forceinline__ float blo(unsigned w) { return __uint_as_float(w << 16); }
__device__ __forceinline__ float bhi(unsigned w) { return __uint_as_float(w & 0xffff0000u); }
__device__ __forceinline__ float wave_sum(float v) {
#pragma unroll
    for (int o = 1; o < 64; o <<= 1) v += __shfl_xor(v, o);
    return v;
}
__device__ __forceinline__ float silu_f(float v) { return v / (1.0f + __expf(-v)); }
#define LDS_WAIT() asm volatile("s_waitcnt lgkmcnt(0)" ::: "memory")

namespace pg8 {
constexpr int BM = 256, BK = 64, HALF = 128, HTB = HALF * BK * 2, STAGE_BYTES = 8 * HTB, NXCD = 8, WGM = 4;
__host__ __device__ __forceinline__ int lds_byte(int r, int c) { const int st = (r >> 4) * 2 + (c >> 5), rr = r & 15, cc = c & 31, ob = rr * 64 + cc * 2; return st * 1024 + (ob ^ (((ob >> 9) & 1) << 5)); }
__host__ __device__ __forceinline__ void stage_rc(int b, int& R, int& C) { const int st = b / 1024, sb = b % 1024, swz = sb ^ (((sb >> 9) & 1) << 5); R = (st >> 1) * 16 + swz / 64; C = (st & 1) * 32 + (swz % 64) / 2; }
__host__ __device__ __forceinline__ int perm32(int rho) { const int n = rho >> 4, i = rho & 15; return 8 * (i >> 2) + 4 * n + (i & 3); }

struct Unit { const char* A; const char* B; int id; };
struct OutInfo { bf16_t* O; int ldc, mask, r0, c0; };
struct Gemm { int K, lda, ldb; };

struct GridSched {
    int nM, nN, nwg, G, c, rep; const char* A; const char* B; size_t tA, tB; bf16_t* O; int ldc;
    __device__ void init(int nM_, int nN_, int G_, int c_, const void* A_, int lda, const void* B_, int ldb, bf16_t* O_, int ldc_) {
        nM = nM_; nN = nN_; nwg = nM * nN; G = G_; c = c_; rep = 1; A = (const char*)A_; B = (const char*)B_; tA = (size_t)BM * lda * 2; tB = (size_t)BM * ldb * 2; O = O_; ldc = ldc_; }
    __device__ bool next(int i, Unit& u) const {
        const int n_c = c < nwg ? (nwg - c + G - 1) / G : 0; if (n_c == 0 || i / n_c >= rep) return false;
        const long L = (long)(i % n_c) * G + c;
        int wgid = (int)L; { const int q = nwg / NXCD, r = nwg % NXCD, xcd = wgid % NXCD, off = wgid / NXCD; wgid = (xcd < r ? xcd * (q + 1) : r * (q + 1) + (xcd - r) * q) + off; }
        const int nig = WGM * nN, gid = wgid / nig, fm = gid * WGM, gsz = (nM - fm) < WGM ? (nM - fm) : WGM;
        const int pm = fm + ((wgid % nig) % gsz), pn = (wgid % nig) / gsz;
        u.A = A + (size_t)pm * tA; u.B = B + (size_t)pn * tB; u.id = pm | (pn << 16); return true;
    }
    __device__ __forceinline__ void out(const Unit& u, OutInfo& o) const { const int pm = u.id & 0xffff, pn = u.id >> 16;
        o.O = O + (size_t)pm * BM * ldc + (size_t)pn * BM; o.ldc = ldc; o.mask = 0; o.r0 = pm * BM; o.c0 = pn * BM; }
};

struct EpiBf16 {
    static constexpr bool PERM = true;
    __device__ __forceinline__ void operator()(const f32x4 (&acc)[2][2][4][2], const OutInfo& u, int wr, int wc, int fr, int fq) const {
        const int row0 = wr * 64 + fr, col0 = wc * 32 + 8 * fq;
#pragma unroll
        for (int ai = 0; ai < 2; ++ai)
#pragma unroll
            for (int m = 0; m < 4; ++m) { const int row = row0 + ai * HALF + m * 16; bf16_t* rowp = u.O + (size_t)row * u.ldc + col0;
#pragma unroll
                for (int bj = 0; bj < 2; ++bj) { f32x4 v0 = acc[ai][bj][m][0], v1 = acc[ai][bj][m][1];
                    u32x4 w; w.x = cvt_pk_bf16(v0[0], v0[1]); w.y = cvt_pk_bf16(v0[2], v0[3]); w.z = cvt_pk_bf16(v1[0], v1[1]); w.w = cvt_pk_bf16(v1[2], v1[3]);
                    *(u32x4*)(rowp + bj * HALF) = w; } }
    }
};
struct EpiRes {
    static constexpr bool PERM = false;
    const float* baseLat; const float* baseCtx; float* out; const float* gateLat; const float* gateCtx;
    __device__ __forceinline__ void operator()(const f32x4 (&acc)[2][2][4][2], const OutInfo& u, int wr, int wc, int fr, int fq) const {
        const bool isc = u.r0 >= SEQ; const float* base = isc ? baseCtx + (size_t)(u.r0 - SEQ) * DM : baseLat + (size_t)u.r0 * DM;
        const float* gate = isc ? gateCtx : gateLat; float* o = out + (size_t)u.r0 * DM;
        const int col0 = u.c0 + wc * 32 + 4 * fq;
        f32x4 g[2][2];
#pragma unroll
        for (int bj = 0; bj < 2; ++bj)
#pragma unroll
            for (int n = 0; n < 2; ++n) g[bj][n] = *(const f32x4*)(gate + col0 + bj * HALF + n * 16);
#pragma unroll
        for (int ai = 0; ai < 2; ++ai) {
            f32x4 pre[4][2][2];
#pragma unroll
            for (int m = 0; m < 4; ++m)
#pragma unroll
                for (int bj = 0; bj < 2; ++bj)
#pragma unroll
                    for (int n = 0; n < 2; ++n) pre[m][bj][n] = *(const f32x4*)(base + (size_t)(ai * HALF + wr * 64 + m * 16 + fr) * DM + col0 + bj * HALF + n * 16);
#pragma unroll
            for (int m = 0; m < 4; ++m)
#pragma unroll
                for (int bj = 0; bj < 2; ++bj)
#pragma unroll
                    for (int n = 0; n < 2; ++n) *(f32x4*)(o + (size_t)(ai * HALF + wr * 64 + m * 16 + fr) * DM + col0 + bj * HALF + n * 16) = pre[m][bj][n] + g[bj][n] * acc[ai][bj][m][n];
            asm volatile("" ::: "memory");
        }
    }
};
struct EpiResNorm {
    static constexpr bool PERM = true;
    const float* base; float* xr_out; const float* gate; const float* normw; const float* shift; const float* scale;
    bf16_t* xn; float* fout; float* slots; unsigned* cnt; LAS unsigned char* xl;
    __device__ __forceinline__ void operator()(f32x4 (&acc)[2][2][4][2], const OutInfo& u, int wr, int wc, int fr, int fq) const {
        int tid = threadIdx.x; asm volatile("" : "+v"(tid), "+v"(fr), "+v"(fq), "+s"(wr), "+s"(wc));
        const int lane = tid & 63, wid = tid >> 6, pm = u.r0 >> 8, pn = u.c0 >> 8;
        const size_t rbase = (size_t)u.r0 * DM; const int col0 = u.c0 + wc * 32 + 8 * fq;
        {
            const char* ub = (const char*)(base + rbase); char* uo = (char*)(xr_out ? xr_out + rbase : nullptr);
            unsigned lo0 = (unsigned)((wr * 64 + fr) * DM + col0) * 4u;
            f32x4 g[2][2];
#pragma unroll
            for (int bj = 0; bj < 2; ++bj)
#pragma unroll
                for (int n = 0; n < 2; ++n) g[bj][n] = *(const f32x4*)(gate + col0 + bj * HALF + n * 4);
#pragma unroll
            for (int ai = 0; ai < 2; ++ai) {
                f32x4 pre[4][2][2];
#pragma unroll
                for (int m = 0; m < 4; ++m)
#pragma unroll
                    for (int bj = 0; bj < 2; ++bj)
#pragma unroll
                        for (int n = 0; n < 2; ++n) pre[m][bj][n] = __builtin_nontemporal_load((const f32x4*)(ub + lo0 + (unsigned)(((ai * HALF + m * 16) * DM + bj * HALF + n * 4) * 4)));
#pragma unroll
                for (int m = 0; m < 4; ++m)
#pragma unroll
                    for (int bj = 0; bj < 2; ++bj)
#pragma unroll
                        for (int n = 0; n < 2; ++n) { acc[ai][bj][m][n] = pre[m][bj][n] + g[bj][n] * acc[ai][bj][m][n];
                            if (xr_out) *(f32x4*)(uo + lo0 + (unsigned)(((ai * HALF + m * 16) * DM + bj * HALF + n * 4) * 4)) = acc[ai][bj][m][n]; }
#pragma unroll
                for (int m = 0; m < 4; ++m) asm volatile("" : "+v"(acc[ai][0][m][0]), "+v"(acc[ai][0][m][1]), "+v"(acc[ai][1][m][0]), "+v"(acc[ai][1][m][1]), "+v"(lo0) :: "memory");
            }
        }
        LAS float* P = (LAS float*)xl;
        LAS float* Sr = (LAS float*)(xl + 4096);
        LAS unsigned* flag = (LAS unsigned*)(xl + 4096 + 1024);
#pragma unroll
        for (int ai = 0; ai < 2; ++ai)
#pragma unroll
            for (int m = 0; m < 4; ++m) { float sq = 0.f;
#pragma unroll
                for (int bj = 0; bj < 2; ++bj)
#pragma unroll
                    for (int n = 0; n < 2; ++n) { const f32x4 x = acc[ai][bj][m][n]; sq += (x[0] * x[0] + x[1] * x[1]) + (x[2] * x[2] + x[3] * x[3]); }
                sq += __shfl_xor(sq, 16); sq += __shfl_xor(sq, 32);
                if (fq == 0) P[(ai * HALF + wr * 64 + m * 16 + fr) * 4 + wc] = sq; }
        asm volatile("s_waitcnt lgkmcnt(0)" ::: "memory"); __builtin_amdgcn_s_barrier(); asm volatile("" ::: "memory");
        if (tid < 256) { const float tot = (P[tid * 4 + 0] + P[tid * 4 + 1]) + (P[tid * 4 + 2] + P[tid * 4 + 3]);
            __hip_atomic_store(slots + ((size_t)(pm * 256 + tid) * 8 + pn), tot, __ATOMIC_RELAXED, __HIP_MEMORY_SCOPE_AGENT); }
        asm volatile("s_waitcnt vmcnt(0)" ::: "memory");
        if (wid < 4 && lane == 0) __hip_atomic_fetch_add(cnt + 64 * pm, 1u, __ATOMIC_RELAXED, __HIP_MEMORY_SCOPE_AGENT);
        if (wid == 0) {
            unsigned sp = 0; bool dead = false;
            while ((unsigned)__builtin_amdgcn_readfirstlane(__hip_atomic_load(cnt + 64 * pm, __ATOMIC_RELAXED, __HIP_MEMORY_SCOPE_AGENT)) < 32u) {
                __builtin_amdgcn_s_sleep(2); if (++sp > (1u << 24)) { dead = true; break; } }
            __builtin_amdgcn_fence(__ATOMIC_ACQUIRE, "agent");
            if (lane == 0) flag[0] = dead ? 1u : 0u;
        }
        asm volatile("s_waitcnt vmcnt(0) lgkmcnt(0)" ::: "memory"); __builtin_amdgcn_s_barrier(); asm volatile("" ::: "memory");
        if (tid < 256) { const float* sl = slots + (size_t)(pm * 256 + tid) * 8; float tot = 0.f;
#pragma unroll
            for (int t = 0; t < 8; ++t) tot += __hip_atomic_load(sl + t, __ATOMIC_RELAXED, __HIP_MEMORY_SCOPE_AGENT);
            float r = rsqrtf(tot * (1.0f / DM) + 1e-6f); if (flag[0]) r = __builtin_nanf("");
            Sr[tid] = r; }
        asm volatile("s_waitcnt lgkmcnt(0)" ::: "memory"); __builtin_amdgcn_s_barrier(); asm volatile("" ::: "memory");
#pragma unroll
        for (int bj = 0; bj < 2; ++bj) { const int col = col0 + bj * HALF;
            f32x4 w0 = *(const f32x4*)(normw + col), w1 = *(const f32x4*)(normw + col + 4), s0 = {0.f, 0.f, 0.f, 0.f}, s1 = s0;
            if (shift) { w0 = w0 * (*(const f32x4*)(scale + col) + 1.0f); w1 = w1 * (*(const f32x4*)(scale + col + 4) + 1.0f); s0 = *(const f32x4*)(shift + col); s1 = *(const f32x4*)(shift + col + 4); }
#pragma unroll
            for (int ai = 0; ai < 2; ++ai)
#pragma unroll
                for (int m = 0; m < 4; ++m) { const int rl = ai * HALF + wr * 64 + m * 16 + fr; const float rs = Sr[rl];
                    const f32x4 y0 = (acc[ai][bj][m][0] * rs) * w0 + s0, y1 = (acc[ai][bj][m][1] * rs) * w1 + s1;
                    if (fout) { *(f32x4*)(fout + rbase + (size_t)rl * DM + col) = y0; *(f32x4*)(fout + rbase + (size_t)rl * DM + col + 4) = y1; }
                    else { u32x4 o; o.x = cvt_pk_bf16(y0[0], y0[1]); o.y = cvt_pk_bf16(y0[2], y0[3]); o.z = cvt_pk_bf16(y1[0], y1[1]); o.w = cvt_pk_bf16(y1[2], y1[3]); *(u32x4*)(xn + rbase + (size_t)rl * DM + col) = o; } } }
        asm volatile("s_waitcnt lgkmcnt(0)" ::: "memory"); __builtin_amdgcn_s_barrier(); asm volatile("" ::: "memory");
    }
};
struct EpiGlaOut {
    static constexpr bool PERM = true;
    const bf16_t* Z; const float* onorm; bf16_t* og; float* slots; unsigned* cnt; LAS unsigned char* xl;
    __device__ __forceinline__ void operator()(f32x4 (&acc)[2][2][4][2], const OutInfo& u, int wr, int wc, int fr, int fq) const {
        int tid = threadIdx.x; asm volatile("" : "+v"(tid), "+v"(fr), "+v"(fq), "+s"(wr), "+s"(wc));
        const int lane = tid & 63, wid = tid >> 6, L = u.r0, nh = L & 1, cc = (L >> 1) & 31, h = L >> 6, pair = L >> 1;
        LAS float* P = (LAS float*)xl; LAS float* Sr = (LAS float*)(xl + 4096); LAS unsigned* flag = (LAS unsigned*)(xl + 4096 + 1024);
#pragma unroll
        for (int ai = 0; ai < 2; ++ai)
#pragma unroll
            for (int m = 0; m < 4; ++m) { float sq = 0.f;
#pragma unroll
                for (int bj = 0; bj < 2; ++bj)
#pragma unroll
                    for (int n = 0; n < 2; ++n) { const f32x4 x = acc[ai][bj][m][n]; sq += (x[0] * x[0] + x[1] * x[1]) + (x[2] * x[2] + x[3] * x[3]); }
                sq += __shfl_xor(sq, 16); sq += __shfl_xor(sq, 32);
                if (fq == 0) P[(ai * HALF + wr * 64 + m * 16 + fr) * 4 + wc] = sq; }
        asm volatile("s_waitcnt lgkmcnt(0)" ::: "memory"); __builtin_amdgcn_s_barrier(); asm volatile("" ::: "memory");
        if (tid < 256) { const float tot = (P[tid * 4 + 0] + P[tid * 4 + 1]) + (P[tid * 4 + 2] + P[tid * 4 + 3]);
            __hip_atomic_store(slots + ((size_t)(pair * 256 + tid) * 2 + nh), tot, __ATOMIC_RELAXED, __HIP_MEMORY_SCOPE_AGENT); }
        asm volatile("s_waitcnt vmcnt(0)" ::: "memory");
        if (wid < 4 && lane == 0) __hip_atomic_fetch_add(cnt + 64 * pair, 1u, __ATOMIC_RELAXED, __HIP_MEMORY_SCOPE_AGENT);
        if (wid == 0) {
            unsigned sp = 0; bool dead = false;
            while ((unsigned)__builtin_amdgcn_readfirstlane(__hip_atomic_load(cnt + 64 * pair, __ATOMIC_RELAXED, __HIP_MEMORY_SCOPE_AGENT)) < 8u) {
                __builtin_amdgcn_s_sleep(2); if (++sp > (1u << 24)) { dead = true; break; } }
            __builtin_amdgcn_fence(__ATOMIC_ACQUIRE, "agent");
            if (lane == 0) flag[0] = dead ? 1u : 0u;
        }
        asm volatile("s_waitcnt vmcnt(0) lgkmcnt(0)" ::: "memory"); __builtin_amdgcn_s_barrier(); asm volatile("" ::: "memory");
        if (tid < 256) { const float* sl = slots + (size_t)(pair * 256 + tid) * 2;
            const float tot = __hip_atomic_load(sl, __ATOMIC_RELAXED, __HIP_MEMORY_SCOPE_AGENT) + __hip_atomic_load(sl + 1, __ATOMIC_RELAXED, __HIP_MEMORY_SCOPE_AGENT);
            float r = rsqrtf(tot * (1.0f / 512.f) + 1e-6f); if (flag[0]) r = __builtin_nanf("");
            Sr[tid] = r; }
        asm volatile("s_waitcnt lgkmcnt(0)" ::: "memory"); __builtin_amdgcn_s_barrier(); asm volatile("" ::: "memory");
        const int dv0 = nh * 256 + wc * 32 + 8 * fq; const size_t tok0 = (size_t)cc * 256;
#pragma unroll
        for (int bj = 0; bj < 2; ++bj) { const int dv = dv0 + bj * HALF; const f32x4 w0 = *(const f32x4*)(onorm + dv), w1 = *(const f32x4*)(onorm + dv + 4);
#pragma unroll
            for (int ai = 0; ai < 2; ++ai) {
                u32x4 gw[4];
#pragma unroll
                for (int m = 0; m < 4; ++m) gw[m] = __builtin_nontemporal_load((const u32x4*)(Z + (tok0 + ai * HALF + wr * 64 + m * 16 + fr) * GLN + 4096 + h * 512 + dv));
#pragma unroll
                for (int m = 0; m < 4; ++m) { const int rl = ai * HALF + wr * 64 + m * 16 + fr; const float rs = Sr[rl];
                    const f32x4 y0 = (acc[ai][bj][m][0] * rs) * w0, y1 = (acc[ai][bj][m][1] * rs) * w1;
                    u32x4 o; o.x = cvt_pk_bf16(y0[0] * silu_f(blo(gw[m].x)), y0[1] * silu_f(bhi(gw[m].x))); o.y = cvt_pk_bf16(y0[2] * silu_f(blo(gw[m].y)), y0[3] * silu_f(bhi(gw[m].y)));
                    o.z = cvt_pk_bf16(y1[0] * silu_f(blo(gw[m].z)), y1[1] * silu_f(bhi(gw[m].z))); o.w = cvt_pk_bf16(y1[2] * silu_f(blo(gw[m].w)), y1[3] * silu_f(bhi(gw[m].w)));
                    *(u32x4*)(og + (tok0 + rl) * DM + h * 512 + dv) = o; } } }
        asm volatile("s_waitcnt lgkmcnt(0)" ::: "memory"); __builtin_amdgcn_s_barrier(); asm volatile("" ::: "memory");
    }
};
struct EpiPart {
    static constexpr bool PERM = false;
    float* part;
    __device__ __forceinline__ void operator()(const f32x4 (&acc)[2][2][4][2], const OutInfo& u, int wr, int wc, int fr, int fq) const {
        float* o = part + (size_t)u.r0 * DM; const int col0 = u.c0 + wc * 32 + 4 * fq;
#pragma unroll
        for (int bj = 0; bj < 2; ++bj)
#pragma unroll
            for (int n = 0; n < 2; ++n) { const int col = col0 + bj * HALF + n * 16;
#pragma unroll
                for (int ai = 0; ai < 2; ++ai)
#pragma unroll
                    for (int m = 0; m < 4; ++m) *(f32x4*)(o + (size_t)(ai * HALF + wr * 64 + m * 16 + fr) * DM + col) = acc[ai][bj][m][n]; }
    }
};
struct MiniSched {
    int G, c, n; const char* A; const char* B; size_t tB;
    __device__ bool next(int i, Unit& u) const { const int L = i * G + c; if (L >= n) return false; u.id = L;
        u.A = A + (size_t)(L >> 3) * 1024; u.B = B + (size_t)(L & 7) * tB + (size_t)(L >> 3) * 1024; return true; }
    __device__ __forceinline__ void out(const Unit& u, OutInfo& o) const { o.O = nullptr; o.ldc = 0; o.mask = 0; o.r0 = (u.id >> 3) * BM; o.c0 = (u.id & 7) * BM; }
};

template <class Epi, class Sched>
__device__ __forceinline__ void gemm_phase(LAS unsigned char* lds, const Gemm g, const Sched& S, const Epi& E) {
    const int tid = threadIdx.x, wid = __builtin_amdgcn_readfirstlane(tid >> 6), lane = tid & 63, wr = wid >> 2, wc = wid & 3, fr = lane & 15, fq = lane >> 4;
    int K = g.K; asm volatile("" : "+s"(K)); const int nt = K / BK;
    unsigned voffA[2], voffB[2];
#pragma unroll
    for (int i = 0; i < 2; ++i) { int R, C; stage_rc(tid * 16 + i * 8192, R, C); const int Rb = Epi::PERM ? ((R & ~31) + perm32(R & 31)) : R;
        voffA[i] = (unsigned)(R * g.lda + C) * 2u; voffB[i] = (unsigned)(Rb * g.ldb + C) * 2u; }
    const size_t kstep = (size_t)(BK * 2);
    const size_t hstepA = (size_t)HALF * g.lda * 2, hstepB = (size_t)HALF * g.ldb * 2;
    const unsigned ldsw = (unsigned)wid * 1024u;
    const int aoff = lds_byte(wr * 64 + fr, fq * 8), boff = lds_byte(wc * 32 + fr, fq * 8);
#define PG8_SA(b, h) (((b) * 2 + (h)) * HTB)
#define PG8_SB(b, h) ((4 + (b) * 2 + (h)) * HTB)
#define PG8_STAGE(bufoff, gbase, voff) do { _Pragma("unroll") for (int _i = 0; _i < 2; ++_i) \
        __builtin_amdgcn_global_load_lds((const unsigned*)((const char*)(gbase) + (voff)[_i]), (LAS unsigned*)(lds + (bufoff) + ldsw + _i * 8192), 16, 0, 0); } while (0)
#define PG8_LDA(dst, b, h) do { _Pragma("unroll") for (int m = 0; m < 4; ++m) _Pragma("unroll") for (int k = 0; k < 2; ++k) dst[m][k] = *(const LAS bf16x8*)(lds + PG8_SA(b, h) + aoff + m * 2048 + k * 1024); } while (0)
#define PG8_LDB(dst, b, h) do { _Pragma("unroll") for (int n = 0; n < 2; ++n) _Pragma("unroll") for (int k = 0; k < 2; ++k) dst[n][k] = *(const LAS bf16x8*)(lds + PG8_SB(b, h) + boff + n * 2048 + k * 1024); } while (0)
#define PG8_MMA(ai, bj, At, Bt) do { __builtin_amdgcn_s_setprio(1); _Pragma("unroll") for (int m = 0; m < 4; ++m) _Pragma("unroll") for (int n = 0; n < 2; ++n) _Pragma("unroll") for (int k = 0; k < 2; ++k) \
        acc[ai][bj][m][n] = __builtin_amdgcn_mfma_f32_16x16x32_bf16(Bt[n][k], At[m][k], acc[ai][bj][m][n], 0, 0, 0); __builtin_amdgcn_s_setprio(0); } while (0)
#define PG8_WAIT_V(n) asm volatile("s_waitcnt vmcnt(" #n ")" ::: "memory")
#define PG8_WAIT_L(n) asm volatile("s_waitcnt lgkmcnt(" #n ")" ::: "memory")
#define PG8_BAR __builtin_amdgcn_s_barrier()
#define PG8_SCHED __builtin_amdgcn_sched_barrier(0)
    Unit cur, nxt; int ui = 0;
    if (!S.next(0, cur)) return;
    f32x4 acc[2][2][4][2];
#pragma unroll
    for (int a = 0; a < 2; ++a)
#pragma unroll
        for (int b = 0; b < 2; ++b)
#pragma unroll
            for (int m = 0; m < 4; ++m)
#pragma unroll
                for (int n = 0; n < 2; ++n) acc[a][b][m][n] = (f32x4){0.f, 0.f, 0.f, 0.f};
    bf16x8 At[4][2], B0[2][2], B1[2][2];
    const char* cA = cur.A; const char* cB = cur.B;
    PG8_STAGE(PG8_SB(0, 0), cB, voffB); PG8_STAGE(PG8_SB(0, 1), cB + hstepB, voffB); PG8_STAGE(PG8_SA(0, 0), cA, voffA); PG8_STAGE(PG8_SA(0, 1), cA + hstepA, voffA);
    if (wr == 1) PG8_BAR;
    PG8_WAIT_V(2); PG8_BAR;
    PG8_STAGE(PG8_SB(1, 0), cB + kstep, voffB); PG8_STAGE(PG8_SA(1, 0), cA + kstep, voffA); PG8_STAGE(PG8_SB(1, 1), cB + hstepB + kstep, voffB);
    PG8_WAIT_V(6); PG8_BAR;
    for (;;) {
        const bool has_next = S.next(ui + 1, nxt);
        const char* nA = has_next ? nxt.A : cA; const char* nB = has_next ? nxt.B : cB;
        for (int t = 0; t < nt; t += 2) {
            const bool last = (t == nt - 2);
            const char* a1 = cA + (size_t)(t + 1) * kstep;
            const char* a2 = last ? nA : cA + (size_t)(t + 2) * kstep; const char* b2 = last ? nB : cB + (size_t)(t + 2) * kstep;
            const char* a3 = a2 + kstep; const char* b3 = b2 + kstep;
            PG8_LDB(B0, 0, 0); PG8_LDB(B1, 0, 1); PG8_SCHED; PG8_LDA(At, 0, 0); PG8_STAGE(PG8_SA(1, 1), a1 + hstepA, voffA);
            PG8_WAIT_V(8); PG8_WAIT_L(0); PG8_BAR; PG8_MMA(0, 0, At, B0); PG8_MMA(0, 1, At, B1); PG8_BAR; PG8_SCHED;
            PG8_LDA(At, 0, 1); PG8_STAGE(PG8_SB(0, 0), b2, voffB); PG8_STAGE(PG8_SB(0, 1), b2 + hstepB, voffB); PG8_STAGE(PG8_SA(0, 0), a2, voffA);
            PG8_WAIT_V(8); PG8_WAIT_L(0); PG8_BAR; PG8_MMA(1, 0, At, B0); PG8_MMA(1, 1, At, B1); PG8_BAR; PG8_SCHED;
            PG8_LDB(B0, 1, 0); PG8_LDB(B1, 1, 1); PG8_SCHED; PG8_LDA(At, 1, 0); PG8_STAGE(PG8_SA(0, 1), a2 + hstepA, voffA);
            PG8_WAIT_V(8); PG8_WAIT_L(0); PG8_BAR; PG8_MMA(0, 0, At, B0); PG8_MMA(0, 1, At, B1); PG8_BAR; PG8_SCHED;
            PG8_LDA(At, 1, 1); PG8_STAGE(PG8_SB(1, 0), b3, voffB); PG8_STAGE(PG8_SB(1, 1), b3 + hstepB, voffB); PG8_STAGE(PG8_SA(1, 0), a3, voffA);
            PG8_WAIT_V(8); PG8_WAIT_L(0); PG8_BAR; PG8_MMA(1, 0, At, B0); PG8_MMA(1, 1, At, B1); PG8_BAR; PG8_SCHED;
        }
        if (wr == 0) PG8_BAR;
        { OutInfo oi; S.out(cur, oi); E(acc, oi, wr, wc, fr, fq); }
        if (!has_next) break;
#pragma unroll
        for (int a = 0; a < 2; ++a)
#pragma unroll
            for (int b = 0; b < 2; ++b)
#pragma unroll
                for (int m = 0; m < 4; ++m)
#pragma unroll
                    for (int n = 0; n < 2; ++n) acc[a][b][m][n] = (f32x4){0.f, 0.f, 0.f, 0.f};
        cur = nxt; cA = nA; cB = nB; ++ui;
        if (wr == 1) PG8_BAR;
    }
    PG8_WAIT_V(0);
    PG8_BAR;
#undef PG8_SA
#undef PG8_SB
#undef PG8_STAGE
#undef PG8_LDA
#undef PG8_LDB
#undef PG8_MMA
#undef PG8_WAIT_V
#undef PG8_WAIT_L
#undef PG8_BAR
#undef PG8_SCHED
}
}

struct Params {
    const float* in[35];
    float* out;
    unsigned char* ws;
    int ph_lo, ph_hi;
};

struct Ctx {
    LAS unsigned char* lds;
    int tid, lane, wave, G, bid, gw, NGW;
};

__device__ __forceinline__ void transpose_item(const float* W, int K, int N, bf16_t* WT, int mode, LAS float* scr, int item, int lane) {
    const int nblk = N / 32, kb = item / nblk, nb = item % nblk, k0 = 64 * kb, n0 = 32 * nb;
    int d0 = n0;
    if (mode == 1) d0 = (n0 < 3072) ? n0 : (n0 < 3104 ? n0 + 3072 : n0 - 32);
#pragma unroll 8
    for (int i = 0; i < 32; ++i) { const int kk = 2 * i + (lane >> 5); scr[kk * 33 + (lane & 31)] = __builtin_nontemporal_load(W + (size_t)(k0 + kk) * N + n0 + (lane & 31)); }
    LDS_WAIT(); asm volatile("" ::: "memory");
    const int c = lane & 7;
#pragma unroll
    for (int j = 0; j < 4; ++j) { const int n = (lane >> 3) + 8 * j; const LAS float* s = scr + (8 * c) * 33 + n;
        u32x4 o; o.x = pk2(s[0 * 33], s[1 * 33]); o.y = pk2(s[2 * 33], s[3 * 33]); o.z = pk2(s[4 * 33], s[5 * 33]); o.w = pk2(s[6 * 33], s[7 * 33]);
        *(u32x4*)(WT + (size_t)(d0 + n) * K + k0 + 8 * c) = o; }
    LDS_WAIT(); asm volatile("" ::: "memory");
}

__device__ __forceinline__ void transpose_item64(const float* W, int K, int N, bf16_t* WT, LAS float* scr, int item, int lane) {
    const int nblk = N / 64, kb = item / nblk, nb = item % nblk, k0 = 64 * kb, n0 = 64 * nb;
    const int lr = lane >> 4, lc = 4 * (lane & 15);
#pragma unroll 8
    for (int i = 0; i < 16; ++i) { const int kk = 4 * i + lr; const f32x4 v = __builtin_nontemporal_load((const f32x4*)(W + (size_t)(k0 + kk) * N + n0 + lc));
        LAS float* d = scr + kk * 65 + lc; d[0] = v.x; d[1] = v.y; d[2] = v.z; d[3] = v.w; }
    LDS_WAIT(); asm volatile("" ::: "memory");
    const int c = lane & 7;
#pragma unroll
    for (int j = 0; j < 8; ++j) { const int n = (lane >> 3) + 8 * j; const LAS float* s = scr + (8 * c) * 65 + n;
        u32x4 o; o.x = pk2(s[0 * 65], s[1 * 65]); o.y = pk2(s[2 * 65], s[3 * 65]); o.z = pk2(s[4 * 65], s[5 * 65]); o.w = pk2(s[6 * 65], s[7 * 65]);
        *(u32x4*)(WT + (size_t)(n0 + n) * K + k0 + 8 * c) = o; }
    LDS_WAIT(); asm volatile("" ::: "memory");
}

__device__ __forceinline__ void phase_prologue(const Params& p, const Ctx& C) {
    LAS float* scr = (LAS float*)(C.lds + C.wave * 16640);
    unsigned char* ws = p.ws;
    constexpr int I0 = 32 * 61, I1 = 8 * 24, I2 = 4 * 32, I3 = 32 * 32, I4 = 32 * 176;
    constexpr int NIT = I0 + I1 + I2 + I3 + I4;
    for (int rp_ = 0; rp_ < 1 + (int)((REP_MASK) & 1u); ++rp_)
    for (int it = C.gw; it < NIT; it += C.NGW) {
        int r = it;
        if (r < I0) { transpose_item64(p.in[7], 2048, 3904, (bf16_t*)(ws + WS_W0IN), scr, r, C.lane); continue; } r -= I0;
        if (r < I1) { transpose_item64(p.in[10], 512, 1536, (bf16_t*)(ws + WS_W0QB), scr, r, C.lane); continue; } r -= I1;
        if (r < I2) { transpose_item64(p.in[12], 256, 2048, (bf16_t*)(ws + WS_W0KVB), scr, r, C.lane); continue; } r -= I2;
        if (r < I3) { transpose_item64(p.in[13], 2048, 2048, (bf16_t*)(ws + WS_W0OUT), scr, r, C.lane); continue; } r -= I3;
        transpose_item64(p.in[15], 2048, DFF2, (bf16_t*)(ws + WS_W0UP), scr, r, C.lane);
    }
    float* mod = (float*)(ws + WS_MOD);
    for (int it = C.gw; it < 1536; it += C.NGW) {
        const int L = it / 768, r = it % 768, kc = r / 48, ng = r % 48;
        const float* W = L ? p.in[19] : p.in[4]; const float* bias = L ? p.in[20] : p.in[5];
        const int n = ng * 256 + C.lane * 4, k0 = kc * 128;
        f32x4 ac = {0.f, 0.f, 0.f, 0.f}, ax = {0.f, 0.f, 0.f, 0.f};
        for (int half = 0; half < 2; ++half) {
            const float cv = p.in[1][k0 + half * 64 + C.lane], xv = p.in[3][k0 + half * 64 + C.lane];
            const float av = silu_f(cv), bv = silu_f(xv);
            const float* Wr = W + (size_t)(k0 + half * 64) * NMOD + n;
#pragma unroll 8
            for (int kk = 0; kk < 64; ++kk) { const float a = __shfl(av, kk), b = __shfl(bv, kk); const f32x4 w = __builtin_nontemporal_load((const f32x4*)(Wr + (size_t)kk * NMOD)); ac += a * w; ax += b * w; }
        }
        if (kc == 0) { const f32x4 b4 = *(const f32x4*)(bias + n); ac += b4; ax += b4; }
        float* m0 = mod + (size_t)(L * 2 + 0) * NMOD + n; float* m1 = mod + (size_t)(L * 2 + 1) * NMOD + n;
#pragma unroll
        for (int j = 0; j < 4; ++j) { atomicAdd(m0 + j, ac[j]); atomicAdd(m1 + j, ax[j]); }
    }
}

__device__ __forceinline__ void tail_transposes(const Params& p, const Ctx& C, int set, int nunits) {
    const int rounds = (nunits + C.G - 1) / C.G, nfull = nunits - (rounds - 1) * C.G;
    int wg = C.bid, nwg = C.G;
    if (nfull > 0 && nfull < C.G) { if (C.bid < nfull) return; wg = C.bid - nfull; nwg = C.G - nfull; }
    LAS float* scr = (LAS float*)(C.lds + C.wave * 16640);
    unsigned char* ws = p.ws;
    constexpr int I3 = 32 * 32, I4 = 32 * 176, I5 = 88 * 32, I6 = 32 * 193;
    const int NIT = set == 0 ? I6 : (set == 1 ? I5 : I3 + I4 + I5);
    for (int it = wg * 8 + C.wave; it < NIT; it += nwg * 8) {
        int r = it;
        if (set == 0) { transpose_item(p.in[22], 2048, 6176, (bf16_t*)(ws + WS_W1IN), 1, scr, r, C.lane); continue; }
        if (set == 1) { transpose_item64(p.in[18], DFF, 2048, (bf16_t*)(ws + WS_W0DN), scr, r, C.lane); continue; }
        if (r < I3) { transpose_item64(p.in[28], 2048, 2048, (bf16_t*)(ws + WS_W1OUT), scr, r, C.lane); continue; } r -= I3;
        if (r < I4) { transpose_item64(p.in[30], 2048, DFF2, (bf16_t*)(ws + WS_W1UP), scr, r, C.lane); continue; } r -= I4;
        transpose_item64(p.in[33], DFF, 2048, (bf16_t*)(ws + WS_W1DN), scr, r, C.lane);
    }
}

__device__ __forceinline__ void phase_normmod(const Params& p, const Ctx& C, const float* srcLat, const float* srcCtx, int row_lo, int nrows, const float* normw, int L, int o_shift, int o_scale, int npart, const float* pgate, bool write_xr) {
    bf16_t* XN = (bf16_t*)(p.ws + WS_XN); const float* mod = (const float*)(p.ws + WS_MOD);
    for (int row = row_lo + C.gw; row < nrows; row += C.NGW) {
        const bool isc = row >= SEQ; const float* src = isc ? srcCtx + (size_t)(row - SEQ) * DM : srcLat + (size_t)row * DM;
        const float* mv = mod + (size_t)(L * 2 + (isc ? 1 : 0)) * NMOD;
        f32x4 v[8]; float ss = 0.f;
#pragma unroll
        for (int j = 0; j < 8; ++j) { v[j] = __builtin_nontemporal_load((const f32x4*)(src + 4 * C.lane + 256 * j)); ss += (v[j].x * v[j].x + v[j].y * v[j].y) + (v[j].z * v[j].z + v[j].w * v[j].w); }
        if (npart > 0 && isc) {
            const float* pp = (const float*)(p.ws + WS_PART) + (size_t)(row - SEQ) * DM + 4 * C.lane; ss = 0.f;
#pragma unroll
            for (int j = 0; j < 8; ++j) { f32x4 a = {0.f, 0.f, 0.f, 0.f};
                for (int k = 0; k < npart; ++k) a += *(const f32x4*)(pp + (size_t)k * 256 * DM + 256 * j);
                v[j] += *(const f32x4*)(pgate + 4 * C.lane + 256 * j) * a; ss += (v[j].x * v[j].x + v[j].y * v[j].y) + (v[j].z * v[j].z + v[j].w * v[j].w); }
            if (write_xr) { float* xr = (float*)(p.ws + WS_XR) + (size_t)row * DM;
#pragma unroll
                for (int j = 0; j < 8; ++j) *(f32x4*)(xr + 4 * C.lane + 256 * j) = v[j]; } }
        const float rstd = rsqrtf(wave_sum(ss) * (1.0f / DM) + 1e-6f);
#pragma unroll
        for (int j = 0; j < 8; ++j) { const int col = 4 * C.lane + 256 * j;
            const f32x4 w = *(const f32x4*)(normw + col), sh = *(const f32x4*)(mv + o_shift * DM + col), sc = *(const f32x4*)(mv + o_scale * DM + col);
            const f32x4 y = (v[j] * rstd) * w * (sc + 1.0f) + sh;
            u32x2 o; o.x = pk2(y.x, y.y); o.y = pk2(y.z, y.w); *(u32x2*)(XN + (size_t)row * DM + col) = o; }
    }
}

__device__ __forceinline__ void rope_cs(int pos, int i, float& cs, float& sn) {
    const float inv = exp2f(-(float)i * 0.83048202372184058696f);
    float r = ((float)pos * inv) * 0.15915494309189533577f; r = r - floorf(r);
    sn = __builtin_amdgcn_sinf(r); cs = __builtin_amdgcn_cosf(r);
}
__device__ __forceinline__ void phase_mixprep0(const Params& p, const Ctx& C) {
    const bf16_t* Z = (const bf16_t*)(p.ws + WS_Z0); bf16_t* KVN = (bf16_t*)(p.ws + WS_KVN); bf16_t* QN = (bf16_t*)(p.ws + WS_QN); bf16_t* KR = (bf16_t*)(p.ws + WS_KR); bf16_t* OA = (bf16_t*)(p.ws + WS_OA);
    const float* conv_a = p.in[8]; const float* q_norm = p.in[9]; const float* kv_norm = p.in[11];
    const int lane = C.lane;
    for (int row = C.gw; row < NTOK; row += C.NGW) {
        const bf16_t* z = Z + (size_t)row * ABN; const bool isc = row >= SEQ;
        const bool hasp = (row != 0) && (row != SEQ), hasn = (row != SEQ - 1) && (row != NTOK - 1);
        const u32x2 kvw = *(const u32x2*)(z + 4 * lane); const u32x4 qw = *(const u32x4*)(z + 320 + 8 * lane); const unsigned short krw = z[256 + lane];
        u32x4 ax[2], ab[2], acv[2], pax[2], pac[2], nax[2], nac[2];
#pragma unroll
        for (int j = 0; j < 2; ++j) { const int ch = 8 * lane + 512 * j;
            ax[j] = *(const u32x4*)(z + 832 + ch); ab[j] = *(const u32x4*)(z + 1856 + ch); acv[j] = *(const u32x4*)(z + 2880 + ch);
            pax[j] = (u32x4){0, 0, 0, 0}; pac[j] = pax[j]; nax[j] = pax[j]; nac[j] = pax[j];
            if (hasp) { pax[j] = *(const u32x4*)(z - ABN + 832 + ch); pac[j] = *(const u32x4*)(z - ABN + 2880 + ch); }
            if (hasn) { nax[j] = *(const u32x4*)(z + ABN + 832 + ch); nac[j] = *(const u32x4*)(z + ABN + 2880 + ch); } }
        {
            const u32x2 w = kvw; float a0 = blo(w.x), a1 = bhi(w.x), a2 = blo(w.y), a3 = bhi(w.y);
            const float rstd = rsqrtf(wave_sum(a0 * a0 + a1 * a1 + a2 * a2 + a3 * a3) * (1.0f / 256.f) + 1e-6f);
            const f32x4 g = *(const f32x4*)(kv_norm + 4 * lane);
            u32x2 o; o.x = pk2(a0 * rstd * g.x, a1 * rstd * g.y); o.y = pk2(a2 * rstd * g.z, a3 * rstd * g.w); *(u32x2*)(KVN + (size_t)row * 256 + 4 * lane) = o;
        }
        {
            const u32x4 w = qw; float a[8] = {blo(w.x), bhi(w.x), blo(w.y), bhi(w.y), blo(w.z), bhi(w.z), blo(w.w), bhi(w.w)};
            float ss = 0.f;
#pragma unroll
            for (int e = 0; e < 8; ++e) ss += a[e] * a[e];
            const float rstd = rsqrtf(wave_sum(ss) * (1.0f / 512.f) + 1e-6f);
            const f32x4 g0 = *(const f32x4*)(q_norm + 8 * lane), g1 = *(const f32x4*)(q_norm + 8 * lane + 4);
            u32x4 o; o.x = pk2(a[0] * rstd * g0.x, a[1] * rstd * g0.y); o.y = pk2(a[2] * rstd * g0.z, a[3] * rstd * g0.w); o.z = pk2(a[4] * rstd * g1.x, a[5] * rstd * g1.y); o.w = pk2(a[6] * rstd * g1.z, a[7] * rstd * g1.w);
            *(u32x4*)(QN + (size_t)row * 512 + 8 * lane) = o;
        }
        {
            const float x = bf2f(krw); const float xp = __shfl_xor(x, 16); const float rot = (lane & 16) ? xp : -xp;
            float cs = 1.f, sn = 0.f;
            if (!isc) rope_cs(lane < 32 ? (row >> 6) : (row & 63), lane & 15, cs, sn);
            KR[(size_t)row * 64 + lane] = (bf16_t)f2bf(x * cs + rot * sn);
        }
        {
#pragma unroll
            for (int j = 0; j < 2; ++j) { const int ch = 8 * lane + 512 * j;
                float o[8];
#pragma unroll
                for (int e = 0; e < 4; ++e) {
                    const float w0l = conv_a[ch + 2 * e], w1l = conv_a[1024 + ch + 2 * e], w2l = conv_a[2048 + ch + 2 * e];
                    const float w0h = conv_a[ch + 2 * e + 1], w1h = conv_a[1024 + ch + 2 * e + 1], w2h = conv_a[2048 + ch + 2 * e + 1];
                    o[2 * e] = blo(ab[j][e]) * (w0l * blo(pac[j][e]) * blo(pax[j][e]) + w1l * blo(acv[j][e]) * blo(ax[j][e]) + w2l * blo(nac[j][e]) * blo(nax[j][e]));
                    o[2 * e + 1] = bhi(ab[j][e]) * (w0h * bhi(pac[j][e]) * bhi(pax[j][e]) + w1h * bhi(acv[j][e]) * bhi(ax[j][e]) + w2h * bhi(nac[j][e]) * bhi(nax[j][e]));
                }
                u32x4 w; w.x = pk2(o[0], o[1]); w.y = pk2(o[2], o[3]); w.z = pk2(o[4], o[5]); w.w = pk2(o[6], o[7]);
                *(u32x4*)(OA + (size_t)row * DM + ch) = w; }
        }
    }
}

namespace attn {
constexpr int NW = 8, QBLK = 32, KVBLK = 64;
constexpr float SCALE = 0.07216878364870322f;
constexpr float THR = 8.f;
constexpr int SHM_V = KVBLK * 128 * 2, SHM_K = KVBLK * 128 * 2, SHM_KR = KVBLK * 64 * 2;
constexpr int OFF_V = 0, OFF_K = 2 * SHM_V, OFF_WS = OFF_K + 2 * SHM_K, OFF_KR = OFF_WS + NW * 64 * 4, OFF_QR = OFF_KR + 2 * SHM_KR, LDS_BYTES = OFF_QR + 256 * 128;
#define KSWZ(row, colB) ((row) * 256 + ((colB) ^ (((row) & 7) << 4)))
#define KSWZ2(row, colB) ((row) * 128 + ((colB) ^ (((row) & 7) << 4)))
#define SBAR() __builtin_amdgcn_sched_barrier(0)
__device__ __forceinline__ int crow(int r, int hi) { return (r & 3) + 8 * (r >> 2) + 4 * hi; }
__device__ __forceinline__ void partialSM(f32x16& p0, f32x16& p1, float& m_reg, float& mn, float& alpha) {
    constexpr float Cc = SCALE * 1.4426950408889634f;
    float pmax = p0[0];
#pragma unroll
    for (int r = 1; r < 16; ++r) pmax = fmaxf(pmax, p0[r]);
#pragma unroll
    for (int r = 0; r < 16; ++r) pmax = fmaxf(pmax, p1[r]);
    { auto rr = __builtin_amdgcn_permlane32_swap(__float_as_uint(pmax), __float_as_uint(pmax), false, false);
      pmax = fmaxf(__uint_as_float(rr[0]), __uint_as_float(rr[1])); }
    if (__builtin_expect(__all(pmax - m_reg <= THR / SCALE), 1)) { mn = m_reg; alpha = 1.f; }
    else { mn = fmaxf(m_reg, pmax); alpha = __builtin_amdgcn_exp2f((m_reg - mn) * Cc); m_reg = mn; }
    const float mnC = -mn * Cc;
#pragma unroll
    for (int r = 0; r < 16; ++r) p0[r] = fmaf(p0[r], Cc, mnC);
#pragma unroll
    for (int r = 0; r < 16; ++r) p1[r] = fmaf(p1[r], Cc, mnC);
#pragma unroll
    for (int r = 0; r < 16; ++r) p0[r] = __builtin_amdgcn_exp2f(p0[r]);
}
__device__ __forceinline__ void finishSM(f32x16& p0, f32x16& p1, float alpha, float& l_reg, bf16x8& pa0, bf16x8& pa1, bf16x8& pa2, bf16x8& pa3) {
#pragma unroll
    for (int r = 0; r < 16; ++r) p1[r] = __builtin_amdgcn_exp2f(p1[r]);
    float ps = 0;
#pragma unroll
    for (int r = 0; r < 16; ++r) ps += p0[r];
#pragma unroll
    for (int r = 0; r < 16; ++r) ps += p1[r];
    { auto rr = __builtin_amdgcn_permlane32_swap(__float_as_uint(ps), __float_as_uint(ps), false, false);
      ps = __uint_as_float(rr[0]) + __uint_as_float(rr[1]); }
    l_reg = l_reg * alpha + ps;
#define PK4(P, BASE, OUT) do { unsigned a0 = cvt_pk_bf16(P[BASE + 0], P[BASE + 1]), a1 = cvt_pk_bf16(P[BASE + 2], P[BASE + 3]);   \
    unsigned b0 = cvt_pk_bf16(P[BASE + 4], P[BASE + 5]), b1 = cvt_pk_bf16(P[BASE + 6], P[BASE + 7]);                              \
    auto r0 = __builtin_amdgcn_permlane32_swap(a0, b0, false, false); auto r1 = __builtin_amdgcn_permlane32_swap(a1, b1, false, false); \
    u32x4 w = {r0[0], r1[0], r0[1], r1[1]}; OUT = *reinterpret_cast<bf16x8*>(&w); } while (0)
    PK4(p0, 0, pa0); PK4(p0, 8, pa1); PK4(p1, 0, pa2); PK4(p1, 8, pa3);
#undef PK4
}
__device__ __forceinline__ void qkt(f32x16& p0, f32x16& p1, const char* Ks, const char* Krs, const char* Qrs, const bf16x8* qr, int r32, int hi, int qrow) {
    p0 = f32x16{}; p1 = f32x16{};
    asm volatile("" : "+v"(r32), "+v"(qrow));
#pragma unroll
    for (int d0 = 0; d0 < 8; ++d0) { const int cb = (d0 * 16 + hi * 8) * 2;
        const bf16x8 b0 = *reinterpret_cast<const bf16x8*>(Ks + KSWZ(r32, cb));
        const bf16x8 b1 = *reinterpret_cast<const bf16x8*>(Ks + KSWZ(32 + r32, cb));
        p0 = __builtin_amdgcn_mfma_f32_32x32x16_bf16(b0, qr[d0], p0, 0, 0, 0);
        p1 = __builtin_amdgcn_mfma_f32_32x32x16_bf16(b1, qr[d0], p1, 0, 0, 0); }
#pragma unroll
    for (int d0 = 0; d0 < 4; ++d0) { const int cb = (d0 * 16 + hi * 8) * 2;
        const bf16x8 b0 = *reinterpret_cast<const bf16x8*>(Krs + KSWZ2(r32, cb));
        const bf16x8 b1 = *reinterpret_cast<const bf16x8*>(Krs + KSWZ2(32 + r32, cb));
        const bf16x8 qf = *reinterpret_cast<const bf16x8*>(Qrs + KSWZ2(qrow, cb));
        p0 = __builtin_amdgcn_mfma_f32_32x32x16_bf16(b0, qf, p0, 0, 0, 0);
        p1 = __builtin_amdgcn_mfma_f32_32x32x16_bf16(b1, qf, p1, 0, 0, 0); }
}
__device__ __forceinline__ int v_st(int k, int c) { const int kk = (k & ~0xC) | ((k & 4) << 1) | ((k & 8) >> 1); return ((kk >> 3) * 4 + (c >> 5)) * 512 + ((kk & 7) * 32 + (c & 31)) * 2; }
__device__ __forceinline__ int v_rd_base(int lane) { return ((lane & 3) << 3) | (((lane >> 2) & 3) << 6) | (((lane >> 4) & 1) << 5) | (((lane >> 5) & 1) << 8); }
constexpr int v_rd_off(int d0, int ks, int half) { return d0 * 512 + ks * 4096 + half * 2048; }
template <int OFF> __device__ __forceinline__ s16x4 tr_read(int vb) {
    s16x4 r; asm volatile("ds_read_b64_tr_b16 %0, %1 offset:%2" : "=&v"(r) : "v"(vb), "i"(OFF) : "memory"); return r;
}
template <int D0> __device__ __forceinline__ void pv_one(f32x16& od, int vb, bf16x8 pa0, bf16x8 pa1, bf16x8 pa2, bf16x8 pa3) {
    const s16x4 l0 = tr_read<v_rd_off(D0, 0, 0)>(vb), h0 = tr_read<v_rd_off(D0, 0, 1)>(vb), l1 = tr_read<v_rd_off(D0, 1, 0)>(vb), h1 = tr_read<v_rd_off(D0, 1, 1)>(vb);
    const s16x4 l2 = tr_read<v_rd_off(D0, 2, 0)>(vb), h2 = tr_read<v_rd_off(D0, 2, 1)>(vb), l3 = tr_read<v_rd_off(D0, 3, 0)>(vb), h3 = tr_read<v_rd_off(D0, 3, 1)>(vb);
    asm volatile("s_waitcnt lgkmcnt(0)" ::: "memory"); SBAR();
#define PK(L, H) (bf16x8){L[0], L[1], L[2], L[3], H[0], H[1], H[2], H[3]}
    od = __builtin_amdgcn_mfma_f32_32x32x16_bf16(pa0, PK(l0, h0), od, 0, 0, 0);
    od = __builtin_amdgcn_mfma_f32_32x32x16_bf16(pa1, PK(l1, h1), od, 0, 0, 0);
    od = __builtin_amdgcn_mfma_f32_32x32x16_bf16(pa2, PK(l2, h2), od, 0, 0, 0);
    od = __builtin_amdgcn_mfma_f32_32x32x16_bf16(pa3, PK(l3, h3), od, 0, 0, 0);
#undef PK
}
__device__ __forceinline__ void pv_d0(f32x16* o, int vb, bf16x8 pa0, bf16x8 pa1, bf16x8 pa2, bf16x8 pa3) {
    pv_one<0>(o[0], vb, pa0, pa1, pa2, pa3); pv_one<1>(o[1], vb, pa0, pa1, pa2, pa3); pv_one<2>(o[2], vb, pa0, pa1, pa2, pa3); pv_one<3>(o[3], vb, pa0, pa1, pa2, pa3);
}

__device__ __forceinline__ void unit(const bf16_t* __restrict__ Qh, const bf16_t* __restrict__ Kh, const bf16_t* __restrict__ Vh, const bf16_t* __restrict__ KRh,
                                     bf16_t* __restrict__ Ob, int seq, int grow0, char* lds) {
    constexpr int LDQ = 1536, LDK = 2048, LDO = 2048;
    const int tid = threadIdx.x, wid = tid >> 6, lane = tid & 63, r32 = lane & 31, hi = lane >> 5;
    char* V_lds = lds + OFF_V; char* K_lds = lds + OFF_K; char* Kr_lds = lds + OFF_KR; char* Qr_lds = lds + OFF_QR;
    float* wsf = (float*)(lds + OFF_WS) + wid * 64; float* li_l = wsf; float* al_l = wsf + 32;
    float m_reg = -1e30f, l_reg = 0; f32x16 o[4] = {}; bf16x8 qr[8];
    const bf16_t* Qw = Qh + (long)(wid * QBLK + r32) * LDQ + hi * 8;
#pragma unroll
    for (int d0 = 0; d0 < 8; ++d0) qr[d0] = *reinterpret_cast<const bf16x8*>(Qw + d0 * 16);
    {
        const int row = tid >> 1, half = tid & 1; const bf16_t* qp = Qh + (long)row * LDQ + 128 + half * 32;
        u32x4 w[4];
#pragma unroll
        for (int i = 0; i < 4; ++i) w[i] = *(const u32x4*)(qp + 8 * i);
        float x[32];
#pragma unroll
        for (int i = 0; i < 4; ++i)
#pragma unroll
            for (int e = 0; e < 4; ++e) { x[8 * i + 2 * e] = blo(w[i][e]); x[8 * i + 2 * e + 1] = bhi(w[i][e]); }
        float y[32];
        const int pos = grow0 < 0 ? 0 : (half == 0 ? ((grow0 + row) >> 6) : ((grow0 + row) & 63));
#pragma unroll
        for (int i = 0; i < 16; ++i) { float cs = 1.f, sn = 0.f; if (grow0 >= 0) rope_cs(pos, i, cs, sn);
            y[i] = x[i] * cs - x[16 + i] * sn; y[16 + i] = x[16 + i] * cs + x[i] * sn; }
#pragma unroll
        for (int i = 0; i < 4; ++i) { u32x4 ov; ov.x = pk2(y[8 * i], y[8 * i + 1]); ov.y = pk2(y[8 * i + 2], y[8 * i + 3]); ov.z = pk2(y[8 * i + 4], y[8 * i + 5]); ov.w = pk2(y[8 * i + 6], y[8 * i + 7]);
            *(u32x4*)(Qr_lds + KSWZ2(row, (half * 32 + 8 * i) * 2)) = ov; }
    }
    const int qrow = wid * QBLK + r32;
    const int sr = tid >> 4, sc = (tid & 15) * 8, vst0 = v_st(sr, sc), vst1 = v_st(32 + sr, sc);
    const int krr = tid >> 3, krc = (tid & 7) * 8;
    const int vb0 = (int)(uintptr_t)V_lds + v_rd_base(lane);
    struct { bf16x8 vs0, vs1, ks0, ks1, kr; } sr_[1];
#define LD8(p) (*reinterpret_cast<const bf16x8*>(p))
    const unsigned off0 = (unsigned)(sr * LDK + sc) * 2u, off1 = off0 + 32u * LDK * 2u, offr = (unsigned)(krr * 64 + krc) * 2u;
#define SLOAD(i, k0) do { const char* vb_ = (const char*)Vh + (size_t)(k0) * (LDK * 2); const char* kb_ = (const char*)Kh + (size_t)(k0) * (LDK * 2); const char* rb_ = (const char*)KRh + (size_t)(k0) * 128; \
    sr_[i].vs0 = LD8(vb_ + off0); sr_[i].vs1 = LD8(vb_ + off1); sr_[i].ks0 = LD8(kb_ + off0); sr_[i].ks1 = LD8(kb_ + off1); sr_[i].kr = LD8(rb_ + offr); } while (0)
#define SWRITE(b, i) do { *(bf16x8*)(V_lds + (b) * SHM_V + vst0) = sr_[i].vs0;          \
    *(bf16x8*)(V_lds + (b) * SHM_V + vst1) = sr_[i].vs1; const int kc = sc * 2;               \
    *(bf16x8*)(K_lds + (b) * SHM_K + KSWZ(sr, kc)) = sr_[i].ks0;                       \
    *(bf16x8*)(K_lds + (b) * SHM_K + KSWZ(32 + sr, kc)) = sr_[i].ks1;                  \
    *(bf16x8*)(Kr_lds + (b) * SHM_KR + KSWZ2(krr, krc * 2)) = sr_[i].kr; } while (0)
#define SWAIT() asm volatile("s_waitcnt vmcnt(0)" ::: "memory")
#define RESC(a) do { if (__any((a) < 1.f)) { if (hi == 0) al_l[r32] = (a); asm volatile("s_waitcnt lgkmcnt(0)" ::: "memory"); \
    _Pragma("unroll") for (int d = 0; d < 4; ++d) _Pragma("unroll") for (int r = 0; r < 16; ++r) o[d][r] *= al_l[crow(r, hi)]; } } while (0)
    f32x16 pA0, pA1, pB0, pB1; float mnA, mnB, alA, alB; bf16x8 pa0, pa1, pa2, pa3; const int NT = seq / KVBLK;
    constexpr int SE = 0, SO = 0;
    SLOAD(SE, 0); asm volatile("s_waitcnt vmcnt(0)" ::: "memory"); SWRITE(0, SE); __syncthreads();
    qkt(pA0, pA1, K_lds, Kr_lds, Qr_lds, qr, r32, hi, qrow); partialSM(pA0, pA1, m_reg, mnA, alA);
    SLOAD(SO, KVBLK);
    SWAIT(); SWRITE(1, SO); __syncthreads();
    for (int j = 1; j + 1 < NT; j += 2) {
        SBAR(); qkt(pB0, pB1, K_lds + SHM_K, Kr_lds + SHM_KR, Qr_lds, qr, r32, hi, qrow);
        finishSM(pA0, pA1, alA, l_reg, pa0, pa1, pa2, pa3); SBAR();
        SLOAD(SO, (j + 1) * KVBLK); SBAR();
        pv_d0(o, vb0, pa0, pa1, pa2, pa3); partialSM(pB0, pB1, m_reg, mnB, alB);
        __syncthreads(); SWAIT(); SWRITE(0, SE);
        RESC(alB); __syncthreads();
        SBAR(); qkt(pA0, pA1, K_lds, Kr_lds, Qr_lds, qr, r32, hi, qrow);
        finishSM(pB0, pB1, alB, l_reg, pa0, pa1, pa2, pa3); SBAR();
        SLOAD(SE, (j + 2) * KVBLK); SBAR();
        pv_d0(o, vb0 + SHM_V, pa0, pa1, pa2, pa3); partialSM(pA0, pA1, m_reg, mnA, alA);
        __syncthreads(); SWAIT(); SWRITE(1, SO);
        RESC(alA); __syncthreads();
    }
    SBAR(); qkt(pB0, pB1, K_lds + SHM_K, Kr_lds + SHM_KR, Qr_lds, qr, r32, hi, qrow);
    finishSM(pA0, pA1, alA, l_reg, pa0, pa1, pa2, pa3); SBAR();
    pv_d0(o, vb0, pa0, pa1, pa2, pa3); partialSM(pB0, pB1, m_reg, mnB, alB);
    __syncthreads(); RESC(alB);
    finishSM(pB0, pB1, alB, l_reg, pa0, pa1, pa2, pa3); SBAR();
    pv_d0(o, vb0 + SHM_V, pa0, pa1, pa2, pa3);
    if (hi == 0) li_l[r32] = l_reg; asm volatile("s_waitcnt lgkmcnt(0)" ::: "memory");
    float rli[16];
#pragma unroll
    for (int r = 0; r < 16; ++r) rli[r] = __builtin_amdgcn_rcpf(li_l[crow(r, hi)]);
    bf16_t* Ow = Ob + (long)(wid * QBLK) * LDO;
#pragma unroll
    for (int r = 0; r < 16; ++r) { const int orow = crow(r, hi);
#pragma unroll
        for (int d0 = 0; d0 < 4; ++d0) Ow[(long)orow * LDO + d0 * 32 + r32] = (bf16_t)f2bf(o[d0][r] * rli[r]); }
#undef SLOAD
#undef SWRITE
#undef SWAIT
#undef RESC
#undef LD8
}
}

__device__ __forceinline__ void phase_attention(const Params& p, const Ctx& C, char* lds_generic) {
    const bf16_t* Q = (const bf16_t*)(p.ws + WS_Q); const bf16_t* KV = (const bf16_t*)(p.ws + WS_KV); const bf16_t* KR = (const bf16_t*)(p.ws + WS_KR); bf16_t* OA = (bf16_t*)(p.ws + WS_OA);
    for (int u = C.bid; u < 264; u += C.G) {
        int h, row0, key0, nkeys, grow0;
        if (u < 256) { h = u & 7; row0 = (u >> 3) * 256; key0 = 0; nkeys = NTOK; grow0 = row0; }
        else { h = u - 256; row0 = SEQ; key0 = SEQ; nkeys = CTX; grow0 = -1; }
        __syncthreads();
        attn::unit(Q + (size_t)row0 * 1536 + h * 192, KV + (size_t)key0 * 2048 + h * 256, KV + (size_t)key0 * 2048 + h * 256 + 128, KR + (size_t)key0 * 64,
                   OA + (size_t)row0 * DM + 1024 + h * 128, nkeys, grow0, lds_generic);
    }
    __syncthreads();
}

__device__ __forceinline__ void unpack8(const u32x4 w, float (&f)[8]) {
#pragma unroll
    for (int e = 0; e < 4; ++e) { f[2 * e] = blo(w[e]); f[2 * e + 1] = bhi(w[e]); }
}
__device__ __forceinline__ void phase_convact(const Params& p, const Ctx& C, const float* cw, const float* cb, int nrows) {
    const bf16_t* U = (const bf16_t*)(p.ws + WS_U); bf16_t* H = (bf16_t*)(p.ws + WS_H);
    const int nstrip = nrows / 16, nitems = nstrip * 704;
    for (int it = C.bid * 512 + C.tid; it < nitems; it += C.G * 512) {
        const int strip = it / 704, cgp = it % 704, r0 = strip * 16, cg0 = 8 * cgp, cv0 = DFF + 8 * cgp;
        const int lo = r0 >= SEQ ? SEQ : 0, hiE = r0 >= SEQ ? NTOK : SEQ;
        float wg[3][8], wv[3][8], bg[8], bv[8];
#pragma unroll
        for (int k = 0; k < 3; ++k)
#pragma unroll
            for (int e = 0; e < 8; ++e) { wg[k][e] = cw[k * DFF2 + cg0 + e]; wv[k][e] = cw[k * DFF2 + cv0 + e]; }
#pragma unroll
        for (int e = 0; e < 8; ++e) { bg[e] = cb[cg0 + e]; bv[e] = cb[cv0 + e]; }
        const u32x4 zero = {0, 0, 0, 0};
        u32x4 pgw = r0 > lo ? __builtin_nontemporal_load((const u32x4*)(U + (size_t)(r0 - 1) * DFF2 + cg0)) : zero, pvw = r0 > lo ? __builtin_nontemporal_load((const u32x4*)(U + (size_t)(r0 - 1) * DFF2 + cv0)) : zero;
        u32x4 cgw = __builtin_nontemporal_load((const u32x4*)(U + (size_t)r0 * DFF2 + cg0)), cvw = __builtin_nontemporal_load((const u32x4*)(U + (size_t)r0 * DFF2 + cv0));
        for (int rb = r0; rb < r0 + 16; rb += 4) {
            u32x4 ngw[4], nvw[4];
#pragma unroll
            for (int q = 0; q < 4; ++q) { const bool hn = (rb + q + 1) < hiE;
                ngw[q] = hn ? __builtin_nontemporal_load((const u32x4*)(U + (size_t)(rb + q + 1) * DFF2 + cg0)) : zero; nvw[q] = hn ? __builtin_nontemporal_load((const u32x4*)(U + (size_t)(rb + q + 1) * DFF2 + cv0)) : zero; }
#pragma unroll
            for (int q = 0; q < 4; ++q) {
                float pg[8], pv[8], cgv[8], cvv[8], ng[8], nv[8];
                unpack8(pgw, pg); unpack8(pvw, pv); unpack8(cgw, cgv); unpack8(cvw, cvv); unpack8(ngw[q], ng); unpack8(nvw[q], nv);
                float o[8];
#pragma unroll
                for (int e = 0; e < 8; ++e) { const float gsum = wg[0][e] * pg[e] + wg[1][e] * cgv[e] + wg[2][e] * ng[e] + bg[e];
                    const float vsum = wv[0][e] * pv[e] + wv[1][e] * cvv[e] + wv[2][e] * nv[e] + bv[e];
                    o[e] = silu_f(gsum) * vsum; }
                u32x4 w; w.x = pk2(o[0], o[1]); w.y = pk2(o[2], o[3]); w.z = pk2(o[4], o[5]); w.w = pk2(o[6], o[7]);
                *(u32x4*)(H + (size_t)(rb + q) * DFF + cg0) = w;
                pgw = cgw; pvw = cvw; cgw = ngw[q]; cvw = nvw[q];
            }
        }
    }
}

__device__ __forceinline__ size_t aq_off(int h, int c) { return ((size_t)(h * 32 + c) * 256) * 768; }
__device__ __forceinline__ size_t ke_off(int d, int h, int c) { return ((size_t)((d * 4 + h) * 32 + c) * 256) * 256; }
__device__ __forceinline__ size_t kdt_off(int d, int h, int c) { return ((size_t)((d * 4 + h) * NCH + c) * 256) * 256; }
__device__ __forceinline__ size_t bt4_off(int h, int c) { return ((size_t)(h * NCH + c) * 512) * 768; }
__device__ __forceinline__ size_t kvt_off(int d, int h, int c) { return ((size_t)((d * 4 + h) * NCH + c) * 512) * 256; }

__device__ __forceinline__ float logsig16(float x) { return -(fmaxf(-x, 0.f) + __logf(1.0f + __expf(-fabsf(x)))) * (1.0f / 16.0f); }

__device__ __forceinline__ void phase_gla_prep(const Params& p, const Ctx& C) {
    const bf16_t* Z = (const bf16_t*)(p.ws + WS_Z1);
    bf16_t* AQ = (bf16_t*)(p.ws + WS_AQ); bf16_t* KE = (bf16_t*)(p.ws + WS_KE); bf16_t* KDT = (bf16_t*)(p.ws + WS_KDT); bf16_t* BT4 = (bf16_t*)(p.ws + WS_BT4);
    float* DEC = (float*)(p.ws + WS_DEC);
    const float* gfw = p.in[23]; const float* gfb = p.in[24]; const float* gbw = p.in[25]; const float* gbb = p.in[26];
    LAS float* red = (LAS float*)C.lds;
    const int col = C.tid & 63, sub = C.tid >> 6;
    for (int it0 = C.bid; it0 < NCH * 16 * G1REP; it0 += C.G) { const int it = it0 % (NCH * 16);
        const int c = it >> 4, h = (it >> 2) & 3, cb = it & 3; const int j = cb * 64 + col, gc = h * 256 + j;
        float wf[16], wb[16];
#pragma unroll
        for (int r = 0; r < 16; ++r) { wf[r] = gfw[r * 1024 + gc]; wb[r] = gbw[r * 1024 + gc]; }
        const float bf_ = gfb[gc], bb_ = gbb[gc];
        const int tok0 = c * 256 + sub * 32;
        float gf[32], gb[32]; float sf = 0.f, sb = 0.f;
#pragma unroll
        for (int t = 0; t < 32; ++t) {
            const bf16_t* lr = Z + (size_t)(tok0 + t) * GLN + 6144;
            const u32x4 a0 = *(const u32x4*)(lr), a1 = *(const u32x4*)(lr + 8), b0 = *(const u32x4*)(lr + 16), b1 = *(const u32x4*)(lr + 24);
            float xf = bf_, xb = bb_;
#pragma unroll
            for (int e = 0; e < 4; ++e) {
                xf += wf[2 * e] * blo(a0[e]) + wf[2 * e + 1] * bhi(a0[e]) + wf[8 + 2 * e] * blo(a1[e]) + wf[8 + 2 * e + 1] * bhi(a1[e]);
                xb += wb[2 * e] * blo(b0[e]) + wb[2 * e + 1] * bhi(b0[e]) + wb[8 + 2 * e] * blo(b1[e]) + wb[8 + 2 * e + 1] * bhi(b1[e]); }
            gf[t] = logsig16(xf); gb[t] = logsig16(xb); sf += gf[t]; sb += gb[t];
        }
        __syncthreads();
        red[sub * 64 + col] = sf; red[512 + sub * 64 + col] = sb;
        __syncthreads();
        float offf = 0.f, totf = 0.f, offb = 0.f, totb = 0.f;
#pragma unroll
        for (int s = 0; s < 8; ++s) { const float a = red[s * 64 + col], b = red[512 + s * 64 + col]; totf += a; totb += b; if (s < sub) offf += a; if (s > sub) offb += b; }
        if (sub == 0) { DEC[((0 * 4 + h) * NCH + c) * 256 + j] = __expf(totf); DEC[((1 * 4 + h) * NCH + c) * 256 + j] = __expf(totb); }
        float Bf = offf, pb = 0.f;
        unsigned kdf[16], kdb[16]; float kdf_lo = 0.f, kdb_lo = 0.f;
        const bool lat = c < 32;
        bf16_t* aq = AQ + (lat ? aq_off(h, c) : 0); bf16_t* kef = KE + (lat ? ke_off(0, h, c) : 0); bf16_t* keb = KE + (lat ? ke_off(1, h, c) : 0);
#pragma unroll
        for (int tb = 0; tb < 32; tb += 16) {
            unsigned short q8[16], k8[16];
#pragma unroll
            for (int t = 0; t < 16; ++t) { const bf16_t* zr = Z + (size_t)(tok0 + tb + t) * GLN; q8[t] = zr[3072 + gc]; k8[t] = zr[gc]; }
#pragma unroll
            for (int tt = 0; tt < 16; ++tt) { const int t = tb + tt;
                Bf += gf[t]; const float Bb = offb + sb - pb; pb += gb[t];
                const int tl = sub * 32 + t;
                const float q = bf2f(q8[tt]) * 0.0625f, k = bf2f(k8[tt]);
                const float kd_f = k * __expf(totf - Bf), kd_b = k * __expf(totb - Bb);
                if (lat) {
                    aq[(size_t)tl * 768 + j] = (bf16_t)f2bf(q * __expf(Bf)); aq[(size_t)tl * 768 + 256 + j] = (bf16_t)f2bf(q * __expf(Bb));
                    kef[(size_t)tl * 256 + j] = (bf16_t)f2bf(k * __expf(-Bf)); keb[(size_t)tl * 256 + j] = (bf16_t)f2bf(k * __expf(-Bb));
                }
                if (t & 1) { kdf[t >> 1] = pk2(kdf_lo, kd_f); kdb[t >> 1] = pk2(kdb_lo, kd_b); } else { kdf_lo = kd_f; kdb_lo = kd_b; }
            }
        }
        bf16_t* kf = KDT + kdt_off(0, h, c) + (size_t)j * 256 + sub * 32; bf16_t* kb = KDT + kdt_off(1, h, c) + (size_t)j * 256 + sub * 32;
#pragma unroll
        for (int q4 = 0; q4 < 4; ++q4) { *(u32x4*)(kf + 8 * q4) = (u32x4){kdf[4 * q4], kdf[4 * q4 + 1], kdf[4 * q4 + 2], kdf[4 * q4 + 3]};
                                         *(u32x4*)(kb + 8 * q4) = (u32x4){kdb[4 * q4], kdb[4 * q4 + 1], kdb[4 * q4 + 2], kdb[4 * q4 + 3]}; }
    }
    __syncthreads();
    LAS bf16_t* tl = (LAS bf16_t*)(C.lds + 8192 + C.wave * 8448);
    for (int it0 = C.gw; it0 < NCH * 4 * 4 * 8 * G1REP; it0 += C.NGW) { const int it = it0 % (NCH * 4 * 4 * 8);
        const int dvb = it & 7, tb = (it >> 3) & 3, h = (it >> 5) & 3, c = it >> 7;
#pragma unroll
        for (int i = 0; i < 8; ++i) { const int r = i * 8 + (C.lane >> 3), ch = C.lane & 7;
            const u32x4 w = __builtin_nontemporal_load((const u32x4*)(Z + (size_t)(c * 256 + tb * 64 + r) * GLN + 1024 + h * 512 + dvb * 64 + ch * 8));
            LAS unsigned* d = (LAS unsigned*)(tl + r * 66 + ch * 8); d[0] = w.x; d[1] = w.y; d[2] = w.z; d[3] = w.w; }
        LDS_WAIT(); asm volatile("" ::: "memory");
#pragma unroll
        for (int i = 0; i < 8; ++i) { const int dv = i * 8 + (C.lane >> 3), tc = C.lane & 7;
            unsigned short e[8];
#pragma unroll
            for (int k = 0; k < 8; ++k) e[k] = tl[(tc * 8 + k) * 66 + dv];
            u32x4 w; w.x = e[0] | ((unsigned)e[1] << 16); w.y = e[2] | ((unsigned)e[3] << 16); w.z = e[4] | ((unsigned)e[5] << 16); w.w = e[6] | ((unsigned)e[7] << 16);
            *(u32x4*)(BT4 + bt4_off(h, c) + (size_t)(dvb * 64 + dv) * 768 + 512 + tb * 64 + tc * 8) = w; }
        LDS_WAIT(); asm volatile("" ::: "memory");
    }
}

struct G2aSched {
    int G, c; unsigned char* ws;
    __device__ bool next(int i, pg8::Unit& u) const {
        const int L = i * G + c; if (L >= 256) return false;
        u.id = L; const int d = L >> 7;
        u.A = (const char*)((bf16_t*)(ws + WS_AQ) + (size_t)(L & 127) * (256 * 768) + d * 256); u.B = (const char*)((bf16_t*)(ws + WS_KE) + (size_t)L * 65536); return true;
    }
    __device__ __forceinline__ void out(const pg8::Unit& u, pg8::OutInfo& o) const { o.O = (bf16_t*)(ws + WS_AT) + (size_t)u.id * 65536; o.ldc = 256; o.mask = 0; o.r0 = 0; o.c0 = 0; }
};
struct G2bSched {
    int G, c; unsigned char* ws;
    __device__ __forceinline__ static int chunk(int cp, int d) { return cp == 0 ? 32 : (d == 0 ? cp - 1 : cp); }
    __device__ bool next(int i, pg8::Unit& u) const {
        const int L = i * G + c; if (L >= 512) return false;
        u.id = L; const int mh = L & 1, hd = (L >> 1) & 7, h = hd & 3, cc = chunk(L >> 4, hd >> 2);
        u.A = (const char*)((bf16_t*)(ws + WS_BT4) + (size_t)((h * NCH + cc) * 512 + mh * 256) * 768 + 512); u.B = (const char*)((bf16_t*)(ws + WS_KDT) + (size_t)(hd * NCH + cc) * 65536); return true;
    }
    __device__ __forceinline__ void out(const pg8::Unit& u, pg8::OutInfo& o) const { const int L = u.id, mh = L & 1, hd = (L >> 1) & 7, cc = chunk(L >> 4, hd >> 2);
        o.O = (bf16_t*)(ws + WS_KVT) + (size_t)((hd * NCH + cc) * 512 + mh * 256) * 256; o.ldc = 256; o.mask = 0; o.r0 = 0; o.c0 = 0; }
};
struct G4Sched {
    int G, c; unsigned char* ws;
    __device__ bool next(int i, pg8::Unit& u) const {
        const int L0 = i * G + c; if (L0 >= 256) return false;
        const int L = (((L0 >> 4) << 3 | (L0 & 7)) << 1) | ((L0 >> 3) & 1);
        const int nh = L & 1, cc = (L >> 1) & 31, h = L >> 6; u.id = L;
        u.A = (const char*)((bf16_t*)(ws + WS_AQ) + aq_off(h, cc)); u.B = (const char*)((bf16_t*)(ws + WS_BT4) + bt4_off(h, cc) + (size_t)(nh * 256) * 768); return true;
    }
    __device__ __forceinline__ void out(const pg8::Unit& u, pg8::OutInfo& o) const {
        const int L = u.id, nh = L & 1, cc = (L >> 1) & 31, h = L >> 6;
        o.O = (bf16_t*)(ws + WS_O) + (size_t)(cc * 256) * DM + h * 512 + nh * 256; o.ldc = DM; o.mask = 0; o.r0 = L; o.c0 = 0;
    }
};

__device__ __forceinline__ void phase_gla_scan(const Params& p, const Ctx& C) {
    const bf16_t* KVT = (const bf16_t*)(p.ws + WS_KVT); const float* DEC = (const float*)(p.ws + WS_DEC); bf16_t* BT4 = (bf16_t*)(p.ws + WS_BT4);
    for (int it = C.bid * 512 + C.tid; it < 2 * 4 * 512 * 32; it += C.G * 512) {
        const int dk8 = it & 31, dv = (it >> 5) & 511, h = (it >> 14) & 3, d = it >> 16; const int dk = dk8 * 8;
        float S[8];
#pragma unroll
        for (int e = 0; e < 8; ++e) S[e] = 0.f;
        for (int s0 = 0; s0 < NCH; s0 += 3) {
            u32x4 kvw[3]; f32x4 da[3], db[3]; int cc[3];
#pragma unroll
            for (int q = 0; q < 3; ++q) { const int s = s0 + q; const int c = (s == 0) ? 32 : (d == 0 ? s - 1 : 32 - s); cc[q] = c;
                if (s < NCH - 1) { kvw[q] = __builtin_nontemporal_load((const u32x4*)(KVT + kvt_off(d, h, c) + (size_t)dv * 256 + dk));
                    const float* dc = DEC + ((d * 4 + h) * NCH + c) * 256 + dk; da[q] = *(const f32x4*)dc; db[q] = *(const f32x4*)(dc + 4); } }
#pragma unroll
            for (int q = 0; q < 3; ++q) { const int s = s0 + q; const int c = cc[q];
                if (s > 0) { u32x4 w; w.x = pk2(S[0], S[1]); w.y = pk2(S[2], S[3]); w.z = pk2(S[4], S[5]); w.w = pk2(S[6], S[7]);
                    *(u32x4*)(BT4 + bt4_off(h, c) + (size_t)dv * 768 + d * 256 + dk) = w; }
                if (s < NCH - 1) { float f[8]; unpack8(kvw[q], f); const f32x4 d0 = da[q], d1 = db[q];
                    S[0] = d0.x * S[0] + f[0]; S[1] = d0.y * S[1] + f[1]; S[2] = d0.z * S[2] + f[2]; S[3] = d0.w * S[3] + f[3];
                    S[4] = d1.x * S[4] + f[4]; S[5] = d1.y * S[5] + f[5]; S[6] = d1.z * S[6] + f[6]; S[7] = d1.w * S[7] + f[7]; } }
        }
    }
    bf16_t* AQ = (bf16_t*)(p.ws + WS_AQ); const bf16_t* AT = (const bf16_t*)(p.ws + WS_AT);
    for (int it0 = C.bid * 512 + C.tid; it0 < 128 * 256 * 32; it0 += 4 * C.G * 512) {
        u32x4 xw[4], yw[4];
#pragma unroll
        for (int q = 0; q < 4; ++q) { const int it = it0 + q * C.G * 512; if (it < 128 * 256 * 32) { const int j8 = it & 31, i = (it >> 5) & 255, hc = it >> 13;
            const bf16_t* bfw = AT + (size_t)hc * 65536 + (size_t)i * 256 + j8 * 8; xw[q] = __builtin_nontemporal_load((const u32x4*)bfw); yw[q] = __builtin_nontemporal_load((const u32x4*)(bfw + (size_t)128 * 65536)); } }
#pragma unroll
        for (int q = 0; q < 4; ++q) { const int it = it0 + q * C.G * 512; if (it < 128 * 256 * 32) { const int j8 = it & 31, i = (it >> 5) & 255, hc = it >> 13;
            float fx[8], fy[8]; unpack8(xw[q], fx); unpack8(yw[q], fy);
#pragma unroll
            for (int e = 0; e < 8; ++e) { const int j = j8 * 8 + e; fx[e] = (j <= i) ? fx[e] : 0.f; fy[e] = (j >= i) ? fy[e] : 0.f; }
            u32x4 w; w.x = pk2(fx[0] + fy[0], fx[1] + fy[1]); w.y = pk2(fx[2] + fy[2], fx[3] + fy[3]); w.z = pk2(fx[4] + fy[4], fx[5] + fy[5]); w.w = pk2(fx[6] + fy[6], fx[7] + fy[7]);
            *(u32x4*)(AQ + (size_t)hc * 256 * 768 + (size_t)i * 768 + 512 + j8 * 8) = w; } }
    }
}

__device__ __forceinline__ void phase_gla_out(const Params& p, const Ctx& C) {
    const bf16_t* O = (const bf16_t*)(p.ws + WS_O); const bf16_t* Z = (const bf16_t*)(p.ws + WS_Z1); bf16_t* OG = (bf16_t*)(p.ws + WS_OG); const float* onorm = p.in[27];
    const f32x4 g0 = *(const f32x4*)(onorm + 8 * C.lane), g1 = *(const f32x4*)(onorm + 8 * C.lane + 4);
    const float gw8[8] = {g0.x, g0.y, g0.z, g0.w, g1.x, g1.y, g1.z, g1.w};
    for (int row = C.gw; row < SEQ; row += C.NGW) {
#pragma unroll
        for (int h = 0; h < 4; ++h) {
            const u32x4 ow = *(const u32x4*)(O + (size_t)row * DM + h * 512 + 8 * C.lane), gwv = *(const u32x4*)(Z + (size_t)row * GLN + 4096 + h * 512 + 8 * C.lane);
            float o[8], g[8]; unpack8(ow, o); unpack8(gwv, g);
            float ss = 0.f;
#pragma unroll
            for (int e = 0; e < 8; ++e) ss += o[e] * o[e];
            const float rstd = rsqrtf(wave_sum(ss) * (1.0f / 512.f) + 1e-6f);
            float y[8];
#pragma unroll
            for (int e = 0; e < 8; ++e) y[e] = o[e] * rstd * gw8[e] * silu_f(g[e]);
            u32x4 w; w.x = pk2(y[0], y[1]); w.y = pk2(y[2], y[3]); w.z = pk2(y[4], y[5]); w.w = pk2(y[6], y[7]);
            *(u32x4*)(OG + (size_t)row * DM + h * 512 + 8 * C.lane) = w;
        }
    }
}

__device__ __forceinline__ void phase_final(const Params& p, const Ctx& C) {
    const float* XR = (const float*)(p.ws + WS_XR); const float* fw = p.in[34];
    for (int row = C.gw; row < SEQ; row += C.NGW) {
        const float* src = XR + (size_t)row * DM; f32x4 v[8]; float ss = 0.f;
#pragma unroll
        for (int j = 0; j < 8; ++j) { v[j] = *(const f32x4*)(src + 4 * C.lane + 256 * j); ss += (v[j].x * v[j].x + v[j].y * v[j].y) + (v[j].z * v[j].z + v[j].w * v[j].w); }
        const float rstd = rsqrtf(wave_sum(ss) * (1.0f / DM) + 1e-6f);
#pragma unroll
        for (int j = 0; j < 8; ++j) { const int col = 4 * C.lane + 256 * j; const f32x4 w = *(const f32x4*)(fw + col);
            *(f32x4*)(p.out + (size_t)row * DM + col) = (v[j] * rstd) * w; }
    }
}

#define XB_TMO      128
#define XB_XCNT(j)  (256  + 64 * (j))
#define XB_XSUB(j)  (1280 + 64 * (j))
#define XB_XGEN(j)  (2304 + 64 * (j))
#define XB_TOP      3328
#define XB_TOPGEN   3392
#define XCD_BAR_WORDS 3456
#define XB_SPIN_CAP (1u << 22)
__device__ __forceinline__ unsigned xb_ld(unsigned* p)              { return __hip_atomic_load(p, __ATOMIC_RELAXED, __HIP_MEMORY_SCOPE_AGENT); }
__device__ __forceinline__ unsigned xb_add(unsigned* p, unsigned v) { return __hip_atomic_fetch_add(p, v, __ATOMIC_RELAXED, __HIP_MEMORY_SCOPE_AGENT); }
__device__ __forceinline__ unsigned xb_xcc_id() { return (unsigned)__builtin_amdgcn_s_getreg((3 << 11) | 20) & 0xFu; }
#define XB_SPIN(cond, bar) do { unsigned _sp = 0; while (cond) { __builtin_amdgcn_s_sleep(1); \
    if ((++_sp & 255u) == 0u) { if (xb_ld(&(bar)[XB_TMO])) break; if (_sp > XB_SPIN_CAP) { atomicAdd(&(bar)[XB_TMO], 1u); break; } } } } while (0)
struct XcdBarrier { unsigned* bar; unsigned x; volatile LAS unsigned* st; };
__device__ __forceinline__ XcdBarrier xcd_barrier_post(unsigned* bar, volatile LAS unsigned* st) {
    XcdBarrier b; b.bar = bar; b.x = xb_xcc_id(); b.st = st;
    if (threadIdx.x == 0) (void)xb_add(&bar[XB_XCNT(b.x)], 1u);
    return b;
}
__device__ __forceinline__ void xcd_barrier_complete(unsigned* bar, unsigned x, unsigned& nloc, unsigned& nx) {
    const unsigned G = gridDim.x * gridDim.y * gridDim.z;
    unsigned sum, cnt, mine, sp = 0u;
    for (;;) {
        sum = 0u; cnt = 0u; mine = 0u;
#pragma unroll
        for (unsigned j = 0; j < 16; ++j) { const unsigned c = xb_ld(&bar[XB_XCNT(j)]); sum += c; cnt += (c > 0u) ? 1u : 0u; mine = (j == x) ? c : mine; }
        if (sum == G) break;
        __builtin_amdgcn_s_sleep(1);
        if ((++sp & 255u) == 0u) { if (xb_ld(&bar[XB_TMO])) break; if (sp > XB_SPIN_CAP) { atomicAdd(&bar[XB_TMO], 1u); break; } }
    }
    nloc = mine > 0u ? mine : 1u; nx = cnt > 0u ? cnt : 1u;
}
__device__ __forceinline__ void xcd_barrier(const XcdBarrier& b) {
    asm volatile("s_waitcnt vmcnt(0)" ::: "memory");
    __syncthreads();
    if (threadIdx.x == 0) {
        unsigned* bar = b.bar;
        __builtin_amdgcn_s_waitcnt(0);
        unsigned nloc = b.st[0], nx = b.st[1];
        if (nloc == 0u) { xcd_barrier_complete(bar, b.x, nloc, nx); b.st[0] = nloc; b.st[1] = nx; }
        const unsigned old = xb_add(&bar[XB_XSUB(b.x)], 1u);
        const unsigned gen = old / nloc;
        if (old + 1u == (gen + 1u) * nloc) {
            __builtin_amdgcn_fence(__ATOMIC_RELEASE, "agent");
            asm volatile("s_waitcnt vmcnt(0)" ::: "memory");
            const unsigned og = xb_add(&bar[XB_TOP], 1u);
            const unsigned tg = og / nx;
            if (og + 1u == (tg + 1u) * nx) xb_add(&bar[XB_TOPGEN], 1u);
            else XB_SPIN(xb_ld(&bar[XB_TOPGEN]) == tg, bar);
            __builtin_amdgcn_fence(__ATOMIC_ACQUIRE, "agent");
            xb_add(&bar[XB_XGEN(b.x)], 1u);
            asm volatile("s_waitcnt vmcnt(0)" ::: "memory");
        } else {
            XB_SPIN(xb_ld(&bar[XB_XGEN(b.x)]) == gen, bar);
            __builtin_amdgcn_fence(__ATOMIC_ACQUIRE, "agent");
            asm volatile("s_waitcnt vmcnt(0)" ::: "memory");
        }
    }
    __syncthreads();
}

constexpr int LDS_TOTAL = 147456;
__global__ void __launch_bounds__(512, 2) fwd_kernel(Params p) {
    extern __shared__ __attribute__((aligned(16))) unsigned char lds_raw[];
    cg::grid_group grid = cg::this_grid();
    Ctx C; C.lds = (LAS unsigned char*)lds_raw; C.tid = threadIdx.x; C.lane = C.tid & 63; C.wave = __builtin_amdgcn_readfirstlane(C.tid >> 6);
    C.G = gridDim.x; C.bid = blockIdx.x; C.gw = C.bid * 8 + C.wave; C.NGW = C.G * 8;
    unsigned char* ws = p.ws;
    const float* mod = (const float*)(ws + WS_MOD);
    float* XR = (float*)(ws + WS_XR); const bf16_t* XN = (const bf16_t*)(ws + WS_XN);
    const int lo = p.ph_lo, hi = p.ph_hi;
    volatile LAS unsigned* xst = (volatile LAS unsigned*)(C.lds + LDS_TOTAL - 64);
    if (C.tid < 2) xst[C.tid] = 0u;
    __syncthreads();
    XcdBarrier xbar = xcd_barrier_post((unsigned*)ws, xst);
    if (p.ph_hi > 1000) grid.sync();
#ifndef PH_MASK
#define PH_MASK 0xFFFFFFu
#endif
#define IN(k) ((((PH_MASK) >> (k)) & 1u) && lo <= (k) && (k) < hi)
#define RP(k) for (int rp_ = 0; rp_ < 1 + (int)(((REP_MASK) >> (k)) & 1u); ++rp_)
#define SEAM(k) do { if (IN(k) && IN((k) + 1)) { for (int br_ = 0; br_ < BAR_REP; ++br_) xcd_barrier(xbar); } } while (0)
#define GEMM_BF16(nM, nN, Ap, lda_, Bp, ldb_, Kk, Op, ldc_) do { pg8::GridSched S; S.init(nM, nN, C.G, C.bid, Ap, lda_, Bp, ldb_, Op, ldc_); S.rep = GREP; pg8::Gemm g{Kk, lda_, ldb_}; pg8::EpiBf16 E; \
        pg8::gemm_phase<pg8::EpiBf16, pg8::GridSched>(C.lds, g, S, E); } while (0)

    if (IN(0)) { phase_prologue(p, C); } SEAM(0);
    if (IN(1)) RP(1) { phase_normmod(p, C, p.in[0], p.in[2], 0, NTOK, p.in[6], 0, 0, 1, 0, nullptr, false); } SEAM(1);
    if (IN(2)) RP(2) { GEMM_BF16(33, 16, XN, DM, ws + WS_W0IN, DM, DM, (bf16_t*)(ws + WS_Z0), ABN);
                       tail_transposes(p, C, 0, 33 * 16); } SEAM(2);
    if (IN(3)) RP(3) { phase_mixprep0(p, C); } SEAM(3);
    if (IN(4)) RP(4) { GEMM_BF16(33, 6, ws + WS_QN, 512, ws + WS_W0QB, 512, 512, (bf16_t*)(ws + WS_Q), 1536);
                 GEMM_BF16(33, 8, ws + WS_KVN, 256, ws + WS_W0KVB, 256, 256, (bf16_t*)(ws + WS_KV), 2048); } SEAM(4);
    if (IN(5)) RP(5) { phase_attention(p, C, (char*)lds_raw); } SEAM(5);
    if (IN(6)) RP(6) { { pg8::GridSched S; S.init(32, 8, C.G, C.bid, ws + WS_OA, DM, ws + WS_W0OUT, DM, nullptr, 0); S.rep = P6REP; pg8::Gemm g{DM, DM, DM};
                   pg8::EpiResNorm E{p.in[0], XR, mod + 0 * NMOD + 2 * DM, p.in[14], mod + 0 * NMOD + 3 * DM, mod + 0 * NMOD + 4 * DM, (bf16_t*)(ws + WS_XN), nullptr, (float*)(ws + WS_SLOT) + (size_t)0 * 65536, (unsigned*)(ws + WS_CNT) + 0 * 2048, C.lds + pg8::STAGE_BYTES};
                   pg8::gemm_phase<pg8::EpiResNorm, pg8::GridSched>(C.lds, g, S, E); }
                 { pg8::MiniSched S{C.G, C.bid, 32, (const char*)(ws + WS_OA) + (size_t)SEQ * DM * 2, (const char*)(ws + WS_W0OUT), (size_t)256 * DM * 2}; pg8::Gemm g{512, DM, DM};
                   pg8::EpiPart E{(float*)(ws + WS_PART)};
                   pg8::gemm_phase<pg8::EpiPart, pg8::MiniSched>(C.lds, g, S, E); } } SEAM(6);
    if (IN(7)) RP(7) { phase_normmod(p, C, XR, p.in[2], SEQ, NTOK, p.in[14], 0, 3, 4, 4, mod + 1 * NMOD + 2 * DM, true); } SEAM(7);
    if (IN(8)) RP(8) { GEMM_BF16(33, 44, XN, DM, ws + WS_W0UP, DM, DM, (bf16_t*)(ws + WS_U), DFF2); tail_transposes(p, C, 1, 33 * 44); } SEAM(8);
    if (IN(9)) RP(9) { phase_convact(p, C, p.in[16], p.in[17], NTOK); } SEAM(9);
    if (IN(10)) RP(10) { { pg8::GridSched S; S.init(32, 8, C.G, C.bid, ws + WS_H, DFF, ws + WS_W0DN, DFF, nullptr, 0); pg8::Gemm g{DFF, DFF, DFF};
                    pg8::EpiResNorm E{XR, XR, mod + 0 * NMOD + 5 * DM, p.in[21], mod + 2 * NMOD + 0 * DM, mod + 2 * NMOD + 1 * DM, (bf16_t*)(ws + WS_XN), nullptr, (float*)(ws + WS_SLOT) + (size_t)1 * 65536, (unsigned*)(ws + WS_CNT) + 1 * 2048, C.lds + pg8::STAGE_BYTES};
                    pg8::gemm_phase<pg8::EpiResNorm, pg8::GridSched>(C.lds, g, S, E); }
                  { pg8::MiniSched S{C.G, C.bid, 88, (const char*)(ws + WS_H) + (size_t)SEQ * DFF * 2, (const char*)(ws + WS_W0DN), (size_t)256 * DFF * 2}; pg8::Gemm g{512, DFF, DFF};
                    pg8::EpiPart E{(float*)(ws + WS_PART)};
                    pg8::gemm_phase<pg8::EpiPart, pg8::MiniSched>(C.lds, g, S, E); } } SEAM(10);
    if (IN(11)) RP(11) { phase_normmod(p, C, XR, XR + (size_t)SEQ * DM, SEQ, NTOK, p.in[21], 1, 0, 1, 11, mod + 1 * NMOD + 5 * DM, false); } SEAM(11);
    if (IN(12)) RP(12) { GEMM_BF16(33, 25, XN, DM, ws + WS_W1IN, DM, DM, (bf16_t*)(ws + WS_Z1), GLN); tail_transposes(p, C, 2, 33 * 25); } SEAM(12);
    if (IN(13)) RP(13) { phase_gla_prep(p, C); } SEAM(13);
    if (IN(14)) RP(14) { { G2aSched S{C.G, C.bid, ws}; pg8::Gemm g{256, 768, 256}; pg8::EpiBf16 E; pg8::gemm_phase<pg8::EpiBf16, G2aSched>(C.lds, g, S, E); }
                  { G2bSched S{C.G, C.bid, ws}; pg8::Gemm g{256, 768, 256}; pg8::EpiBf16 E; pg8::gemm_phase<pg8::EpiBf16, G2bSched>(C.lds, g, S, E); } } SEAM(14);
    if (IN(15)) RP(15) { phase_gla_scan(p, C); } SEAM(15);
    if (IN(16)) RP(16) { G4Sched S{C.G, C.bid, ws}; pg8::Gemm g{768, 768, 768};
                  pg8::EpiGlaOut E{(const bf16_t*)(ws + WS_Z1), p.in[27], (bf16_t*)(ws + WS_O), (float*)(ws + WS_SLOT) + (size_t)4 * 65536, (unsigned*)(ws + WS_CNT) + 4 * 2048, C.lds + pg8::STAGE_BYTES};
                  pg8::gemm_phase<pg8::EpiGlaOut, G4Sched>(C.lds, g, S, E); } if (IN(16) && IN(18)) xcd_barrier(xbar);
    if (IN(18)) RP(18) { pg8::GridSched S; S.init(32, 8, C.G, C.bid, ws + WS_O, DM, ws + WS_W1OUT, DM, nullptr, 0); pg8::Gemm g{DM, DM, DM};
                  pg8::EpiResNorm E{XR, XR, mod + 2 * NMOD + 2 * DM, p.in[29], mod + 2 * NMOD + 3 * DM, mod + 2 * NMOD + 4 * DM, (bf16_t*)(ws + WS_XN), nullptr, (float*)(ws + WS_SLOT) + (size_t)2 * 65536, (unsigned*)(ws + WS_CNT) + 2 * 2048, C.lds + pg8::STAGE_BYTES};
                  pg8::gemm_phase<pg8::EpiResNorm, pg8::GridSched>(C.lds, g, S, E); } if (IN(18) && IN(20)) xcd_barrier(xbar);
    if (IN(20)) RP(20) { GEMM_BF16(32, 44, XN, DM, ws + WS_W1UP, DM, DM, (bf16_t*)(ws + WS_U), DFF2); } SEAM(20);
    if (IN(21)) RP(21) { phase_convact(p, C, p.in[31], p.in[32], SEQ); } SEAM(21);
    if (IN(22)) RP(22) { pg8::GridSched S; S.init(32, 8, C.G, C.bid, ws + WS_H, DFF, ws + WS_W1DN, DFF, nullptr, 0); pg8::Gemm g{DFF, DFF, DFF};
                  pg8::EpiResNorm E{XR, nullptr, mod + 2 * NMOD + 5 * DM, p.in[34], nullptr, nullptr, nullptr, p.out, (float*)(ws + WS_SLOT) + (size_t)3 * 65536, (unsigned*)(ws + WS_CNT) + 3 * 2048, C.lds + pg8::STAGE_BYTES};
                  pg8::gemm_phase<pg8::EpiResNorm, pg8::GridSched>(C.lds, g, S, E); }
#undef IN
#undef SEAM
}

extern "C" void kernel_launch(void* const* d_in, const int* in_sizes, int n_in, void* d_out, int out_size, void* d_ws, size_t ws_size, hipStream_t stream) {
    static int grid = 0;
    if (grid == 0) {
        if (n_in != 35 || ws_size < WS_END) { fprintf(stderr, "kernel_launch: unexpected n_in %d / ws_size %zu (need %zu)\n", n_in, ws_size, (size_t)WS_END); grid = -1; return; }
        int dev = 0, cus = 0, per_cu = 0;
        (void)hipGetDevice(&dev); (void)hipDeviceGetAttribute(&cus, hipDeviceAttributeMultiprocessorCount, dev);
        if (hipFuncSetAttribute((const void*)fwd_kernel, hipFuncAttributeMaxDynamicSharedMemorySize, LDS_TOTAL) != hipSuccess) { fprintf(stderr, "kernel_launch: hipFuncSetAttribute failed\n"); grid = -1; return; }
        (void)hipOccupancyMaxActiveBlocksPerMultiprocessor(&per_cu, (const void*)fwd_kernel, 512, LDS_TOTAL);
        if (per_cu < 1) { fprintf(stderr, "kernel_launch: occupancy query says %d blocks/CU\n", per_cu); per_cu = 1; }
        (void)hipGetLastError();
        grid = cus;
    }
    if (grid < 0) return;
    (void)hipMemsetAsync((char*)d_ws, 0, WS_MOD + 4 * NMOD * sizeof(float), stream);
    Params p{};
    for (int i = 0; i < 35; ++i) p.in[i] = (const float*)d_in[i];
    p.out = (float*)d_out; p.ws = (unsigned char*)d_ws;
#if N_LAUNCH_MODE == 1
    p.ph_lo = 0; p.ph_hi = NPHASE;
    void* args[] = {&p};
    hipError_t e = hipLaunchCooperativeKernel((const void*)fwd_kernel, dim3(grid), dim3(512), args, LDS_TOTAL, stream);
    if (e != hipSuccess) fprintf(stderr, "cooperative launch failed: %s (grid %d)\n", hipGetErrorString(e), grid);
#else
    for (int ph = 0; ph < NPHASE; ++ph) { p.ph_lo = ph; p.ph_hi = ph + 1; hipLaunchKernelGGL(fwd_kernel, dim3(grid), dim3(512), LDS_TOTAL, stream, p); }
#endif
}
```

```cpp
#include <hip/hip_runtime.h>
#include <hip/hip_cooperative_groups.h>
#include <cstdio>
#include <cstdint>
namespace cg = cooperative_groups;

#define LAS __attribute__((address_space(3)))
typedef unsigned short bf16_t;
typedef short bf16x8 __attribute__((ext_vector_type(8)));
typedef short s16x4 __attribute__((ext_vector_type(4)));
typedef float f32x4 __attribute__((ext_vector_type(4)));
typedef float f32x2 __attribute__((ext_vector_type(2)));
typedef float f32x16 __attribute__((ext_vector_type(16)));
typedef unsigned u32x4 __attribute__((ext_vector_type(4)));
typedef unsigned u32x2 __attribute__((ext_vector_type(2)));

#define REP_MASK 0u
#define BAR_REP 1
#define G1REP 1
#define P6REP 1
#define GREP 1
#ifndef N_LAUNCH_MODE
#define N_LAUNCH_MODE 1
#endif

constexpr int DM = 2048, SEQ = 8192, CTX = 256, NTOK = SEQ + CTX;
constexpr int NMOD = 6 * DM;
constexpr int ABN = 4096;
constexpr int GLN = 6400;
constexpr int DFF = 5632, DFF2 = 11264;
constexpr int NCH = 33;
constexpr int NPHASE = 24;

constexpr size_t MiB = 1u << 20;
constexpr size_t WS_CNT = 64 * 1024;
constexpr size_t WS_SLOT = 2 * MiB;
constexpr size_t WS_MOD = 1 * MiB;
constexpr size_t WS_DEC = 1 * MiB + 512 * 1024;
constexpr size_t WS_W0IN = 4 * MiB, WS_W0QB = 20 * MiB, WS_W0KVB = 21 * MiB + 512 * 1024, WS_W0OUT = 22 * MiB + 512 * 1024,
                 WS_W0UP = 30 * MiB + 512 * 1024, WS_W0DN = 74 * MiB + 512 * 1024;
constexpr size_t WS_KVT = 4 * MiB;
constexpr size_t WS_W1OUT = 96 * MiB + 512 * 1024, WS_W1UP = 104 * MiB + 512 * 1024, WS_W1DN = 148 * MiB + 512 * 1024;
constexpr size_t WS_XN = 171 * MiB;
constexpr size_t WS_KDT = WS_XN;
constexpr size_t WS_XR = 204 * MiB;
constexpr size_t WS_Z0 = 270 * MiB, WS_KVN = 336 * MiB, WS_QN = 341 * MiB, WS_KR = 350 * MiB, WS_Q = 352 * MiB, WS_KV = 377 * MiB, WS_OA = 410 * MiB;
constexpr size_t WS_U = 270 * MiB, WS_H = 452 * MiB;
constexpr size_t WS_Z1 = 270 * MiB, WS_AQ = 374 * MiB, WS_OG = 374 * MiB, WS_KE = 422 * MiB, WS_O = 422 * MiB, WS_BT4 = 454 * MiB, WS_W1IN = 553 * MiB;
constexpr size_t WS_PART = 578 * MiB;
constexpr size_t WS_AT = 578 * MiB;
constexpr size_t WS_END = 610 * MiB;

__device__ __forceinline__ float bf2f(unsigned v) { return __uint_as_float(v << 16); }
__device__ __forceinline__ unsigned f2bf(float f) { unsigned u = __float_as_uint(f); return (u + 0x7fffu + ((u >> 16) & 1u)) >> 16; }
__device__ __forceinline__ unsigned pk2(float lo, float hi) { return f2bf(lo) | (f2bf(hi) << 16); }
__device__ __forceinline__ unsigned cvt_pk_bf16(float lo, float hi) { unsigned r; asm volatile("v_cvt_pk_bf16_f32 %0, %1, %2" : "=v"(r) : "v"(lo), "v"(hi)); return r; }
__device__ __forceinline__ float blo(unsigned w) { return __uint_as_float(w << 16); }
__device__ __forceinline__ float bhi(unsigned w) { return __uint_as_float(w & 0xffff0000u); }
__device__ __forceinline__ float wave_sum(float v) {
#pragma unroll
    for (int o = 1; o < 64; o <<= 1) v += __shfl_xor(v, o);
    return v;
}
__device__ __forceinline__ float silu_f(float v) { return v * __builtin_amdgcn_rcpf(1.0f + __expf(-v)); }
#define LDS_WAIT() asm volatile("s_waitcnt lgkmcnt(0)" ::: "memory")

namespace pg8 {
constexpr int BM = 256, BK = 64, HALF = 128, HTB = HALF * BK * 2, STAGE_BYTES = 8 * HTB, NXCD = 8, WGM = 4;
__host__ __device__ __forceinline__ int lds_byte(int r, int c) { const int st = (r >> 4) * 2 + (c >> 5), rr = r & 15, cc = c & 31, ob = rr * 64 + cc * 2; return st * 1024 + (ob ^ (((ob >> 9) & 1) << 5)); }
__host__ __device__ __forceinline__ void stage_rc(int b, int& R, int& C) { const int st = b / 1024, sb = b % 1024, swz = sb ^ (((sb >> 9) & 1) << 5); R = (st >> 1) * 16 + swz / 64; C = (st & 1) * 32 + (swz % 64) / 2; }
__host__ __device__ __forceinline__ int perm32(int rho) { const int n = rho >> 4, i = rho & 15; return 8 * (i >> 2) + 4 * n + (i & 3); }

struct Unit { const char* A; const char* B; int id; };
struct OutInfo { bf16_t* O; int ldc, mask, r0, c0; };
struct Gemm { int K, lda, ldb; };

struct GridSched {
    int nM, nN, nwg, G, c, rep; const char* A; const char* B; size_t tA, tB; bf16_t* O; int ldc;
    __device__ void init(int nM_, int nN_, int G_, int c_, const void* A_, int lda, const void* B_, int ldb, bf16_t* O_, int ldc_) {
        nM = nM_; nN = nN_; nwg = nM * nN; G = G_; c = c_; rep = 1; A = (const char*)A_; B = (const char*)B_; tA = (size_t)BM * lda * 2; tB = (size_t)BM * ldb * 2; O = O_; ldc = ldc_; }
    __device__ bool next(int i, Unit& u) const {
        const int n_c = c < nwg ? (nwg - c + G - 1) / G : 0; if (n_c == 0 || i / n_c >= rep) return false;
        const long L = (long)(i % n_c) * G + c;
        int wgid = (int)L; { const int q = nwg / NXCD, r = nwg % NXCD, xcd = wgid % NXCD, off = wgid / NXCD; wgid = (xcd < r ? xcd * (q + 1) : r * (q + 1) + (xcd - r) * q) + off; }
        const int nig = WGM * nN, gid = wgid / nig, fm = gid * WGM, gsz = (nM - fm) < WGM ? (nM - fm) : WGM;
        const int pm = fm + ((wgid % nig) % gsz), pn = (wgid % nig) / gsz;
        u.A = A + (size_t)pm * tA; u.B = B + (size_t)pn * tB; u.id = pm | (pn << 16); return true;
    }
    __device__ __forceinline__ void out(const Unit& u, OutInfo& o) const { const int pm = u.id & 0xffff, pn = u.id >> 16;
        o.O = O + (size_t)pm * BM * ldc + (size_t)pn * BM; o.ldc = ldc; o.mask = 0; o.r0 = pm * BM; o.c0 = pn * BM; }
};

struct EpiBf16 {
    static constexpr bool PERM = true;
    __device__ __forceinline__ void operator()(const f32x4 (&acc)[2][2][4][2], const OutInfo& u, int wr, int wc, int fr, int fq) const {
        const int row0 = wr * 64 + fr, col0 = wc * 32 + 8 * fq;
#pragma unroll
        for (int ai = 0; ai < 2; ++ai)
#pragma unroll
            for (int m = 0; m < 4; ++m) { const int row = row0 + ai * HALF + m * 16; bf16_t* rowp = u.O + (size_t)row * u.ldc + col0;
#pragma unroll
                for (int bj = 0; bj < 2; ++bj) { f32x4 v0 = acc[ai][bj][m][0], v1 = acc[ai][bj][m][1];
                    u32x4 w; w.x = cvt_pk_bf16(v0[0], v0[1]); w.y = cvt_pk_bf16(v0[2], v0[3]); w.z = cvt_pk_bf16(v1[0], v1[1]); w.w = cvt_pk_bf16(v1[2], v1[3]);
                    *(u32x4*)(rowp + bj * HALF) = w; } }
    }
};
struct EpiRes {
    static constexpr bool PERM = false;
    const float* baseLat; const float* baseCtx; float* out; const float* gateLat; const float* gateCtx;
    __device__ __forceinline__ void operator()(const f32x4 (&acc)[2][2][4][2], const OutInfo& u, int wr, int wc, int fr, int fq) const {
        const bool isc = u.r0 >= SEQ; const float* base = isc ? baseCtx + (size_t)(u.r0 - SEQ) * DM : baseLat + (size_t)u.r0 * DM;
        const float* gate = isc ? gateCtx : gateLat; float* o = out + (size_t)u.r0 * DM;
        const int col0 = u.c0 + wc * 32 + 4 * fq;
        f32x4 g[2][2];
#pragma unroll
        for (int bj = 0; bj < 2; ++bj)
#pragma unroll
            for (int n = 0; n < 2; ++n) g[bj][n] = *(const f32x4*)(gate + col0 + bj * HALF + n * 16);
#pragma unroll
        for (int ai = 0; ai < 2; ++ai) {
            f32x4 pre[4][2][2];
#pragma unroll
            for (int m = 0; m < 4; ++m)
#pragma unroll
                for (int bj = 0; bj < 2; ++bj)
#pragma unroll
                    for (int n = 0; n < 2; ++n) pre[m][bj][n] = *(const f32x4*)(base + (size_t)(ai * HALF + wr * 64 + m * 16 + fr) * DM + col0 + bj * HALF + n * 16);
#pragma unroll
            for (int m = 0; m < 4; ++m)
#pragma unroll
                for (int bj = 0; bj < 2; ++bj)
#pragma unroll
                    for (int n = 0; n < 2; ++n) *(f32x4*)(o + (size_t)(ai * HALF + wr * 64 + m * 16 + fr) * DM + col0 + bj * HALF + n * 16) = pre[m][bj][n] + g[bj][n] * acc[ai][bj][m][n];
            asm volatile("" ::: "memory");
        }
    }
};
struct EpiResNorm {
    static constexpr bool PERM = true;
    const float* base; float* xr_out; const float* gate; const float* normw; const float* shift; const float* scale;
    bf16_t* xn; float* fout; float* slots; unsigned* cnt; LAS unsigned char* xl;
    __device__ __forceinline__ void operator()(f32x4 (&acc)[2][2][4][2], const OutInfo& u, int wr, int wc, int fr, int fq) const {
        int tid = threadIdx.x; asm volatile("" : "+v"(tid), "+v"(fr), "+v"(fq), "+s"(wr), "+s"(wc));
        const int lane = tid & 63, wid = tid >> 6, pm = u.r0 >> 8, pn = u.c0 >> 8;
        const size_t rbase = (size_t)u.r0 * DM; const int col0 = u.c0 + wc * 32 + 8 * fq;
        {
            const char* ub = (const char*)(base + rbase); char* uo = (char*)(xr_out ? xr_out + rbase : nullptr);
            unsigned lo0 = (unsigned)((wr * 64 + fr) * DM + col0) * 4u;
            f32x4 g[2][2];
#pragma unroll
            for (int bj = 0; bj < 2; ++bj)
#pragma unroll
                for (int n = 0; n < 2; ++n) g[bj][n] = *(const f32x4*)(gate + col0 + bj * HALF + n * 4);
#pragma unroll
            for (int ai = 0; ai < 2; ++ai) {
                f32x4 pre[4][2][2];
#pragma unroll
                for (int m = 0; m < 4; ++m)
#pragma unroll
                    for (int bj = 0; bj < 2; ++bj)
#pragma unroll
                        for (int n = 0; n < 2; ++n) pre[m][bj][n] = __builtin_nontemporal_load((const f32x4*)(ub + lo0 + (unsigned)(((ai * HALF + m * 16) * DM + bj * HALF + n * 4) * 4)));
#pragma unroll
                for (int m = 0; m < 4; ++m)
#pragma unroll
                    for (int bj = 0; bj < 2; ++bj)
#pragma unroll
                        for (int n = 0; n < 2; ++n) { acc[ai][bj][m][n] = pre[m][bj][n] + g[bj][n] * acc[ai][bj][m][n];
                            if (xr_out) *(f32x4*)(uo + lo0 + (unsigned)(((ai * HALF + m * 16) * DM + bj * HALF + n * 4) * 4)) = acc[ai][bj][m][n]; }
#pragma unroll
                for (int m = 0; m < 4; ++m) asm volatile("" : "+v"(acc[ai][0][m][0]), "+v"(acc[ai][0][m][1]), "+v"(acc[ai][1][m][0]), "+v"(acc[ai][1][m][1]), "+v"(lo0) :: "memory");
            }
        }
        LAS float* P = (LAS float*)xl;
        LAS float* Sr = (LAS float*)(xl + 4096);
        LAS unsigned* flag = (LAS unsigned*)(xl + 4096 + 1024);
#pragma unroll
        for (int ai = 0; ai < 2; ++ai)
#pragma unroll
            for (int m = 0; m < 4; ++m) { float sq = 0.f;
#pragma unroll
                for (int bj = 0; bj < 2; ++bj)
#pragma unroll
                    for (int n = 0; n < 2; ++n) { const f32x4 x = acc[ai][bj][m][n]; sq += (x[0] * x[0] + x[1] * x[1]) + (x[2] * x[2] + x[3] * x[3]); }
                sq += __shfl_xor(sq, 16); sq += __shfl_xor(sq, 32);
                if (fq == 0) P[(ai * HALF + wr * 64 + m * 16 + fr) * 4 + wc] = sq; }
        asm volatile("s_waitcnt lgkmcnt(0)" ::: "memory"); __builtin_amdgcn_s_barrier(); asm volatile("" ::: "memory");
        if (tid < 256) { const float tot = (P[tid * 4 + 0] + P[tid * 4 + 1]) + (P[tid * 4 + 2] + P[tid * 4 + 3]);
            __hip_atomic_store(slots + ((size_t)(pm * 256 + tid) * 8 + pn), tot, __ATOMIC_RELAXED, __HIP_MEMORY_SCOPE_AGENT); }
        asm volatile("s_waitcnt vmcnt(0)" ::: "memory");
        if (wid < 4 && lane == 0) __hip_atomic_fetch_add(cnt + 64 * pm, 1u, __ATOMIC_RELAXED, __HIP_MEMORY_SCOPE_AGENT);
        if (wid == 0) {
            unsigned sp = 0; bool dead = false;
            while ((unsigned)__builtin_amdgcn_readfirstlane(__hip_atomic_load(cnt + 64 * pm, __ATOMIC_RELAXED, __HIP_MEMORY_SCOPE_AGENT)) < 32u) {
                __builtin_amdgcn_s_sleep(2); if (++sp > (1u << 24)) { dead = true; break; } }
            __builtin_amdgcn_fence(__ATOMIC_ACQUIRE, "agent");
            if (lane == 0) flag[0] = dead ? 1u : 0u;
        }
        asm volatile("s_waitcnt vmcnt(0) lgkmcnt(0)" ::: "memory"); __builtin_amdgcn_s_barrier(); asm volatile("" ::: "memory");
        if (tid < 256) { const float* sl = slots + (size_t)(pm * 256 + tid) * 8; float tot = 0.f;
#pragma unroll
            for (int t = 0; t < 8; ++t) tot += __hip_atomic_load(sl + t, __ATOMIC_RELAXED, __HIP_MEMORY_SCOPE_AGENT);
            float r = rsqrtf(tot * (1.0f / DM) + 1e-6f); if (flag[0]) r = __builtin_nanf("");
            Sr[tid] = r; }
        asm volatile("s_waitcnt lgkmcnt(0)" ::: "memory"); __builtin_amdgcn_s_barrier(); asm volatile("" ::: "memory");
#pragma unroll
        for (int bj = 0; bj < 2; ++bj) { const int col = col0 + bj * HALF;
            f32x4 w0 = *(const f32x4*)(normw + col), w1 = *(const f32x4*)(normw + col + 4), s0 = {0.f, 0.f, 0.f, 0.f}, s1 = s0;
            if (shift) { w0 = w0 * (*(const f32x4*)(scale + col) + 1.0f); w1 = w1 * (*(const f32x4*)(scale + col + 4) + 1.0f); s0 = *(const f32x4*)(shift + col); s1 = *(const f32x4*)(shift + col + 4); }
#pragma unroll
            for (int ai = 0; ai < 2; ++ai)
#pragma unroll
                for (int m = 0; m < 4; ++m) { const int rl = ai * HALF + wr * 64 + m * 16 + fr; const float rs = Sr[rl];
                    const f32x4 y0 = (acc[ai][bj][m][0] * rs) * w0 + s0, y1 = (acc[ai][bj][m][1] * rs) * w1 + s1;
                    if (fout) { *(f32x4*)(fout + rbase + (size_t)rl * DM + col) = y0; *(f32x4*)(fout + rbase + (size_t)rl * DM + col + 4) = y1; }
                    else { u32x4 o; o.x = cvt_pk_bf16(y0[0], y0[1]); o.y = cvt_pk_bf16(y0[2], y0[3]); o.z = cvt_pk_bf16(y1[0], y1[1]); o.w = cvt_pk_bf16(y1[2], y1[3]); *(u32x4*)(xn + rbase + (size_t)rl * DM + col) = o; } } }
        asm volatile("s_waitcnt lgkmcnt(0)" ::: "memory"); __builtin_amdgcn_s_barrier(); asm volatile("" ::: "memory");
    }
};
struct EpiGlaOut {
    static constexpr bool PERM = true;
    const bf16_t* Z; const float* onorm; bf16_t* og; float* slots; unsigned* cnt; LAS unsigned char* xl;
    __device__ __forceinline__ void operator()(f32x4 (&acc)[2][2][4][2], const OutInfo& u, int wr, int wc, int fr, int fq) const {
        int tid = threadIdx.x; asm volatile("" : "+v"(tid), "+v"(fr), "+v"(fq), "+s"(wr), "+s"(wc));
        const int lane = tid & 63, wid = tid >> 6, L = u.r0, nh = L & 1, cc = (L >> 1) & 31, h = L >> 6, pair = L >> 1;
        LAS float* P = (LAS float*)xl; LAS float* Sr = (LAS float*)(xl + 4096); LAS unsigned* flag = (LAS unsigned*)(xl + 4096 + 1024);
#pragma unroll
        for (int ai = 0; ai < 2; ++ai)
#pragma unroll
            for (int m = 0; m < 4; ++m) { float sq = 0.f;
#pragma unroll
                for (int bj = 0; bj < 2; ++bj)
#pragma unroll
                    for (int n = 0; n < 2; ++n) { const f32x4 x = acc[ai][bj][m][n]; sq += (x[0] * x[0] + x[1] * x[1]) + (x[2] * x[2] + x[3] * x[3]); }
                sq += __shfl_xor(sq, 16); sq += __shfl_xor(sq, 32);
                if (fq == 0) P[(ai * HALF + wr * 64 + m * 16 + fr) * 4 + wc] = sq; }
        asm volatile("s_waitcnt lgkmcnt(0)" ::: "memory"); __builtin_amdgcn_s_barrier(); asm volatile("" ::: "memory");
        if (tid < 256) { const float tot = (P[tid * 4 + 0] + P[tid * 4 + 1]) + (P[tid * 4 + 2] + P[tid * 4 + 3]);
            __hip_atomic_store(slots + ((size_t)(pair * 256 + tid) * 2 + nh), tot, __ATOMIC_RELAXED, __HIP_MEMORY_SCOPE_AGENT); }
        asm volatile("s_waitcnt vmcnt(0)" ::: "memory");
        if (wid < 4 && lane == 0) __hip_atomic_fetch_add(cnt + 64 * pair, 1u, __ATOMIC_RELAXED, __HIP_MEMORY_SCOPE_AGENT);
        if (wid == 0) {
            unsigned sp = 0; bool dead = false;
            while ((unsigned)__builtin_amdgcn_readfirstlane(__hip_atomic_load(cnt + 64 * pair, __ATOMIC_RELAXED, __HIP_MEMORY_SCOPE_AGENT)) < 8u) {
                __builtin_amdgcn_s_sleep(2); if (++sp > (1u << 24)) { dead = true; break; } }
            __builtin_amdgcn_fence(__ATOMIC_ACQUIRE, "agent");
            if (lane == 0) flag[0] = dead ? 1u : 0u;
        }
        asm volatile("s_waitcnt vmcnt(0) lgkmcnt(0)" ::: "memory"); __builtin_amdgcn_s_barrier(); asm volatile("" ::: "memory");
        if (tid < 256) { const float* sl = slots + (size_t)(pair * 256 + tid) * 2;
            const float tot = __hip_atomic_load(sl, __ATOMIC_RELAXED, __HIP_MEMORY_SCOPE_AGENT) + __hip_atomic_load(sl + 1, __ATOMIC_RELAXED, __HIP_MEMORY_SCOPE_AGENT);
            float r = rsqrtf(tot * (1.0f / 512.f) + 1e-6f); if (flag[0]) r = __builtin_nanf("");
            Sr[tid] = r; }
        asm volatile("s_waitcnt lgkmcnt(0)" ::: "memory"); __builtin_amdgcn_s_barrier(); asm volatile("" ::: "memory");
        const int dv0 = nh * 256 + wc * 32 + 8 * fq; const size_t tok0 = (size_t)cc * 256;
#pragma unroll
        for (int bj = 0; bj < 2; ++bj) { const int dv = dv0 + bj * HALF; const f32x4 w0 = *(const f32x4*)(onorm + dv), w1 = *(const f32x4*)(onorm + dv + 4);
#pragma unroll
            for (int ai = 0; ai < 2; ++ai) {
                u32x4 gw[4];
#pragma unroll
                for (int m = 0; m < 4; ++m) gw[m] = __builtin_nontemporal_load((const u32x4*)(Z + (tok0 + ai * HALF + wr * 64 + m * 16 + fr) * GLN + 4096 + h * 512 + dv));
#pragma unroll
                for (int m = 0; m < 4; ++m) { const int rl = ai * HALF + wr * 64 + m * 16 + fr; const float rs = Sr[rl];
                    const f32x4 y0 = (acc[ai][bj][m][0] * rs) * w0, y1 = (acc[ai][bj][m][1] * rs) * w1;
                    u32x4 o; o.x = cvt_pk_bf16(y0[0] * silu_f(blo(gw[m].x)), y0[1] * silu_f(bhi(gw[m].x))); o.y = cvt_pk_bf16(y0[2] * silu_f(blo(gw[m].y)), y0[3] * silu_f(bhi(gw[m].y)));
                    o.z = cvt_pk_bf16(y1[0] * silu_f(blo(gw[m].z)), y1[1] * silu_f(bhi(gw[m].z))); o.w = cvt_pk_bf16(y1[2] * silu_f(blo(gw[m].w)), y1[3] * silu_f(bhi(gw[m].w)));
                    *(u32x4*)(og + (tok0 + rl) * DM + h * 512 + dv) = o; } } }
        asm volatile("s_waitcnt lgkmcnt(0)" ::: "memory"); __builtin_amdgcn_s_barrier(); asm volatile("" ::: "memory");
    }
};
struct EpiPart {
    static constexpr bool PERM = false;
    float* part;
    __device__ __forceinline__ void operator()(const f32x4 (&acc)[2][2][4][2], const OutInfo& u, int wr, int wc, int fr, int fq) const {
        float* o = part + (size_t)u.r0 * DM; const int col0 = u.c0 + wc * 32 + 4 * fq;
#pragma unroll
        for (int bj = 0; bj < 2; ++bj)
#pragma unroll
            for (int n = 0; n < 2; ++n) { const int col = col0 + bj * HALF + n * 16;
#pragma unroll
                for (int ai = 0; ai < 2; ++ai)
#pragma unroll
                    for (int m = 0; m < 4; ++m) *(f32x4*)(o + (size_t)(ai * HALF + wr * 64 + m * 16 + fr) * DM + col) = acc[ai][bj][m][n]; }
    }
};
struct MiniSched {
    int G, c, n; const char* A; const char* B; size_t tB;
    __device__ bool next(int i, Unit& u) const { const int L = i * G + c; if (L >= n) return false; u.id = L;
        u.A = A + (size_t)(L >> 3) * 1024; u.B = B + (size_t)(L & 7) * tB + (size_t)(L >> 3) * 1024; return true; }
    __device__ __forceinline__ void out(const Unit& u, OutInfo& o) const { o.O = nullptr; o.ldc = 0; o.mask = 0; o.r0 = (u.id >> 3) * BM; o.c0 = (u.id & 7) * BM; }
};

template <class Epi, class Sched>
__device__ __forceinline__ void gemm_phase(LAS unsigned char* lds, const Gemm g, const Sched& S, const Epi& E) {
    const int tid = threadIdx.x, wid = __builtin_amdgcn_readfirstlane(tid >> 6), lane = tid & 63, wr = wid >> 2, wc = wid & 3, fr = lane & 15, fq = lane >> 4;
    int K = g.K; asm volatile("" : "+s"(K)); const int nt = K / BK;
    unsigned voffA[2], voffB[2];
#pragma unroll
    for (int i = 0; i < 2; ++i) { int R, C; stage_rc(tid * 16 + i * 8192, R, C); const int Rb = Epi::PERM ? ((R & ~31) + perm32(R & 31)) : R;
        voffA[i] = (unsigned)(R * g.lda + C) * 2u; voffB[i] = (unsigned)(Rb * g.ldb + C) * 2u; }
    const size_t kstep = (size_t)(BK * 2);
    const size_t hstepA = (size_t)HALF * g.lda * 2, hstepB = (size_t)HALF * g.ldb * 2;
    const unsigned ldsw = (unsigned)wid * 1024u;
    const int aoff = lds_byte(wr * 64 + fr, fq * 8), boff = lds_byte(wc * 32 + fr, fq * 8);
#define PG8_SA(b, h) (((b) * 2 + (h)) * HTB)
#define PG8_SB(b, h) ((4 + (b) * 2 + (h)) * HTB)
#define PG8_STAGE(bufoff, gbase, voff) do { _Pragma("unroll") for (int _i = 0; _i < 2; ++_i) \
        __builtin_amdgcn_global_load_lds((const unsigned*)((const char*)(gbase) + (voff)[_i]), (LAS unsigned*)(lds + (bufoff) + ldsw + _i * 8192), 16, 0, 0); } while (0)
#define PG8_LDA(dst, b, h) do { _Pragma("unroll") for (int m = 0; m < 4; ++m) _Pragma("unroll") for (int k = 0; k < 2; ++k) dst[m][k] = *(const LAS bf16x8*)(lds + PG8_SA(b, h) + aoff + m * 2048 + k * 1024); } while (0)
#define PG8_LDB(dst, b, h) do { _Pragma("unroll") for (int n = 0; n < 2; ++n) _Pragma("unroll") for (int k = 0; k < 2; ++k) dst[n][k] = *(const LAS bf16x8*)(lds + PG8_SB(b, h) + boff + n * 2048 + k * 1024); } while (0)
#define PG8_MMA(ai, bj, At, Bt) do { __builtin_amdgcn_s_setprio(1); _Pragma("unroll") for (int m = 0; m < 4; ++m) _Pragma("unroll") for (int n = 0; n < 2; ++n) _Pragma("unroll") for (int k = 0; k < 2; ++k) \
        acc[ai][bj][m][n] = __builtin_amdgcn_mfma_f32_16x16x32_bf16(Bt[n][k], At[m][k], acc[ai][bj][m][n], 0, 0, 0); __builtin_amdgcn_s_setprio(0); } while (0)
#define PG8_WAIT_V(n) asm volatile("s_waitcnt vmcnt(" #n ")" ::: "memory")
#define PG8_WAIT_L(n) asm volatile("s_waitcnt lgkmcnt(" #n ")" ::: "memory")
#define PG8_BAR __builtin_amdgcn_s_barrier()
#define PG8_SCHED __builtin_amdgcn_sched_barrier(0)
    Unit cur, nxt; int ui = 0;
    if (!S.next(0, cur)) return;
    f32x4 acc[2][2][4][2];
#pragma unroll
    for (int a = 0; a < 2; ++a)
#pragma unroll
        for (int b = 0; b < 2; ++b)
#pragma unroll
            for (int m = 0; m < 4; ++m)
#pragma unroll
                for (int n = 0; n < 2; ++n) acc[a][b][m][n] = (f32x4){0.f, 0.f, 0.f, 0.f};
    bf16x8 At[4][2], B0[2][2], B1[2][2];
    const char* cA = cur.A; const char* cB = cur.B;
    PG8_STAGE(PG8_SB(0, 0), cB, voffB); PG8_STAGE(PG8_SB(0, 1), cB + hstepB, voffB); PG8_STAGE(PG8_SA(0, 0), cA, voffA); PG8_STAGE(PG8_SA(0, 1), cA + hstepA, voffA);
    if (wr == 1) PG8_BAR;
    PG8_WAIT_V(2); PG8_BAR;
    PG8_STAGE(PG8_SB(1, 0), cB + kstep, voffB); PG8_STAGE(PG8_SA(1, 0), cA + kstep, voffA); PG8_STAGE(PG8_SB(1, 1), cB + hstepB + kstep, voffB);
    PG8_WAIT_V(6); PG8_BAR;
    for (;;) {
        const bool has_next = S.next(ui + 1, nxt);
        const char* nA = has_next ? nxt.A : cA; const char* nB = has_next ? nxt.B : cB;
        for (int t = 0; t < nt; t += 2) {
            const bool last = (t == nt - 2);
            const char* a1 = cA + (size_t)(t + 1) * kstep;
            const char* a2 = last ? nA : cA + (size_t)(t + 2) * kstep; const char* b2 = last ? nB : cB + (size_t)(t + 2) * kstep;
            const char* a3 = a2 + kstep; const char* b3 = b2 + kstep;
            PG8_LDB(B0, 0, 0); PG8_LDB(B1, 0, 1); PG8_SCHED; PG8_LDA(At, 0, 0); PG8_STAGE(PG8_SA(1, 1), a1 + hstepA, voffA);
            PG8_WAIT_V(8); PG8_WAIT_L(0); PG8_BAR; PG8_MMA(0, 0, At, B0); PG8_MMA(0, 1, At, B1); PG8_BAR; PG8_SCHED;
            PG8_LDA(At, 0, 1); PG8_STAGE(PG8_SB(0, 0), b2, voffB); PG8_STAGE(PG8_SB(0, 1), b2 + hstepB, voffB); PG8_STAGE(PG8_SA(0, 0), a2, voffA);
            PG8_WAIT_V(8); PG8_WAIT_L(0); PG8_BAR; PG8_MMA(1, 0, At, B0); PG8_MMA(1, 1, At, B1); PG8_BAR; PG8_SCHED;
            PG8_LDB(B0, 1, 0); PG8_LDB(B1, 1, 1); PG8_SCHED; PG8_LDA(At, 1, 0); PG8_STAGE(PG8_SA(0, 1), a2 + hstepA, voffA);
            PG8_WAIT_V(8); PG8_WAIT_L(0); PG8_BAR; PG8_MMA(0, 0, At, B0); PG8_MMA(0, 1, At, B1); PG8_BAR; PG8_SCHED;
            PG8_LDA(At, 1, 1); PG8_STAGE(PG8_SB(1, 0), b3, voffB); PG8_STAGE(PG8_SB(1, 1), b3 + hstepB, voffB); PG8_STAGE(PG8_SA(1, 0), a3, voffA);
            PG8_WAIT_V(8); PG8_WAIT_L(0); PG8_BAR; PG8_MMA(1, 0, At, B0); PG8_MMA(1, 1, At, B1); PG8_BAR; PG8_SCHED;
        }
        if (wr == 0) PG8_BAR;
        { OutInfo oi; S.out(cur, oi); E(acc, oi, wr, wc, fr, fq); }
        if (!has_next) break;
#pragma unroll
        for (int a = 0; a < 2; ++a)
#pragma unroll
            for (int b = 0; b < 2; ++b)
#pragma unroll
                for (int m = 0; m < 4; ++m)
#pragma unroll
                    for (int n = 0; n < 2; ++n) acc[a][b][m][n] = (f32x4){0.f, 0.f, 0.f, 0.f};
        cur = nxt; cA = nA; cB = nB; ++ui;
        if (wr == 1) PG8_BAR;
    }
    PG8_WAIT_V(0);
    PG8_BAR;
#undef PG8_SA
#undef PG8_SB
#undef PG8_STAGE
#undef PG8_LDA
#undef PG8_LDB
#undef PG8_MMA
#undef PG8_WAIT_V
#undef PG8_WAIT_L
#undef PG8_BAR
#undef PG8_SCHED
}
}

struct Params {
    const float* in[35];
    float* out;
    unsigned char* ws;
    int ph_lo, ph_hi;
};

struct Ctx {
    LAS unsigned char* lds;
    int tid, lane, wave, G, bid, gw, NGW;
};

__device__ __forceinline__ void transpose_item(const float* W, int K, int N, bf16_t* WT, int mode, LAS float* scr, int item, int lane) {
    const int nblk = N / 32, kb = item / nblk, nb = item % nblk, k0 = 64 * kb, n0 = 32 * nb;
    int d0 = n0;
    if (mode == 1) d0 = (n0 < 3072) ? n0 : (n0 < 3104 ? n0 + 3072 : n0 - 32);
#pragma unroll 8
    for (int i = 0; i < 32; ++i) { const int kk = 2 * i + (lane >> 5); scr[kk * 33 + (lane & 31)] = __builtin_nontemporal_load(W + (size_t)(k0 + kk) * N + n0 + (lane & 31)); }
    LDS_WAIT(); asm volatile("" ::: "memory");
    const int c = lane & 7;
#pragma unroll
    for (int j = 0; j < 4; ++j) { const int n = (lane >> 3) + 8 * j; const LAS float* s = scr + (8 * c) * 33 + n;
        u32x4 o; o.x = pk2(s[0 * 33], s[1 * 33]); o.y = pk2(s[2 * 33], s[3 * 33]); o.z = pk2(s[4 * 33], s[5 * 33]); o.w = pk2(s[6 * 33], s[7 * 33]);
        *(u32x4*)(WT + (size_t)(d0 + n) * K + k0 + 8 * c) = o; }
    LDS_WAIT(); asm volatile("" ::: "memory");
}

__device__ __forceinline__ void transpose_item64(const float* W, int K, int N, bf16_t* WT, LAS float* scr, int item, int lane) {
    const int nblk = N / 64, kb = item / nblk, nb = item % nblk, k0 = 64 * kb, n0 = 64 * nb;
    const int lr = lane >> 4, lc = 4 * (lane & 15);
#pragma unroll 8
    for (int i = 0; i < 16; ++i) { const int kk = 4 * i + lr; const f32x4 v = __builtin_nontemporal_load((const f32x4*)(W + (size_t)(k0 + kk) * N + n0 + lc));
        LAS float* d = scr + kk * 65 + lc; d[0] = v.x; d[1] = v.y; d[2] = v.z; d[3] = v.w; }
    LDS_WAIT(); asm volatile("" ::: "memory");
    const int c = lane & 7;
#pragma unroll
    for (int j = 0; j < 8; ++j) { const int n = (lane >> 3) + 8 * j; const LAS float* s = scr + (8 * c) * 65 + n;
        u32x4 o; o.x = pk2(s[0 * 65], s[1 * 65]); o.y = pk2(s[2 * 65], s[3 * 65]); o.z = pk2(s[4 * 65], s[5 * 65]); o.w = pk2(s[6 * 65], s[7 * 65]);
        *(u32x4*)(WT + (size_t)(n0 + n) * K + k0 + 8 * c) = o; }
    LDS_WAIT(); asm volatile("" ::: "memory");
}

__device__ __forceinline__ void phase_prologue(const Params& p, const Ctx& C) {
    LAS float* scr = (LAS float*)(C.lds + C.wave * 16640);
    unsigned char* ws = p.ws;
    constexpr int I0 = 32 * 61, I1 = 8 * 24, I2 = 4 * 32, I3 = 32 * 32, I4 = 32 * 176;
    constexpr int NIT = I0 + I1 + I2 + I3 + I4;
    for (int rp_ = 0; rp_ < 1 + (int)((REP_MASK) & 1u); ++rp_)
    for (int it = C.gw; it < NIT; it += C.NGW) {
        int r = it;
        if (r < I0) { transpose_item64(p.in[7], 2048, 3904, (bf16_t*)(ws + WS_W0IN), scr, r, C.lane); continue; } r -= I0;
        if (r < I1) { transpose_item64(p.in[10], 512, 1536, (bf16_t*)(ws + WS_W0QB), scr, r, C.lane); continue; } r -= I1;
        if (r < I2) { transpose_item64(p.in[12], 256, 2048, (bf16_t*)(ws + WS_W0KVB), scr, r, C.lane); continue; } r -= I2;
        if (r < I3) { transpose_item64(p.in[13], 2048, 2048, (bf16_t*)(ws + WS_W0OUT), scr, r, C.lane); continue; } r -= I3;
        transpose_item64(p.in[15], 2048, DFF2, (bf16_t*)(ws + WS_W0UP), scr, r, C.lane);
    }
    float* mod = (float*)(ws + WS_MOD);
    for (int it = C.gw; it < 1536; it += C.NGW) {
        const int L = it / 768, r = it % 768, kc = r / 48, ng = r % 48;
        const float* W = L ? p.in[19] : p.in[4]; const float* bias = L ? p.in[20] : p.in[5];
        const int n = ng * 256 + C.lane * 4, k0 = kc * 128;
        f32x4 ac = {0.f, 0.f, 0.f, 0.f}, ax = {0.f, 0.f, 0.f, 0.f};
        for (int half = 0; half < 2; ++half) {
            const float cv = p.in[1][k0 + half * 64 + C.lane], xv = p.in[3][k0 + half * 64 + C.lane];
            const float av = silu_f(cv), bv = silu_f(xv);
            const float* Wr = W + (size_t)(k0 + half * 64) * NMOD + n;
#pragma unroll 8
            for (int kk = 0; kk < 64; ++kk) { const float a = __shfl(av, kk), b = __shfl(bv, kk); const f32x4 w = __builtin_nontemporal_load((const f32x4*)(Wr + (size_t)kk * NMOD)); ac += a * w; ax += b * w; }
        }
        if (kc == 0) { const f32x4 b4 = *(const f32x4*)(bias + n); ac += b4; ax += b4; }
        float* m0 = mod + (size_t)(L * 2 + 0) * NMOD + n; float* m1 = mod + (size_t)(L * 2 + 1) * NMOD + n;
#pragma unroll
        for (int j = 0; j < 4; ++j) { atomicAdd(m0 + j, ac[j]); atomicAdd(m1 + j, ax[j]); }
    }
}

__device__ __forceinline__ void tail_transposes(const Params& p, const Ctx& C, int set, int nunits) {
    const int rounds = (nunits + C.G - 1) / C.G, nfull = nunits - (rounds - 1) * C.G;
    int wg = C.bid, nwg = C.G;
    if (nfull > 0 && nfull < C.G) { if (C.bid < nfull) return; wg = C.bid - nfull; nwg = C.G - nfull; }
    LAS float* scr = (LAS float*)(C.lds + C.wave * 16640);
    unsigned char* ws = p.ws;
    constexpr int I3 = 32 * 32, I4 = 32 * 176, I5 = 88 * 32, I6 = 32 * 193;
    const int NIT = set == 0 ? I6 : (set == 1 ? I5 : I3 + I4 + I5);
    for (int it = wg * 8 + C.wave; it < NIT; it += nwg * 8) {
        int r = it;
        if (set == 0) { transpose_item(p.in[22], 2048, 6176, (bf16_t*)(ws + WS_W1IN), 1, scr, r, C.lane); continue; }
        if (set == 1) { transpose_item64(p.in[18], DFF, 2048, (bf16_t*)(ws + WS_W0DN), scr, r, C.lane); continue; }
        if (r < I3) { transpose_item64(p.in[28], 2048, 2048, (bf16_t*)(ws + WS_W1OUT), scr, r, C.lane); continue; } r -= I3;
        if (r < I4) { transpose_item64(p.in[30], 2048, DFF2, (bf16_t*)(ws + WS_W1UP), scr, r, C.lane); continue; } r -= I4;
        transpose_item64(p.in[33], DFF, 2048, (bf16_t*)(ws + WS_W1DN), scr, r, C.lane);
    }
}

__device__ __forceinline__ void phase_normmod(const Params& p, const Ctx& C, const float* srcLat, const float* srcCtx, int row_lo, int nrows, const float* normw, int L, int o_shift, int o_scale, int npart, const float* pgate, bool write_xr) {
    bf16_t* XN = (bf16_t*)(p.ws + WS_XN); const float* mod = (const float*)(p.ws + WS_MOD);
    for (int row = row_lo + C.gw; row < nrows; row += C.NGW) {
        const bool isc = row >= SEQ; const float* src = isc ? srcCtx + (size_t)(row - SEQ) * DM : srcLat + (size_t)row * DM;
        const float* mv = mod + (size_t)(L * 2 + (isc ? 1 : 0)) * NMOD;
        f32x4 v[8]; float ss = 0.f;
#pragma unroll
        for (int j = 0; j < 8; ++j) { v[j] = __builtin_nontemporal_load((const f32x4*)(src + 4 * C.lane + 256 * j)); ss += (v[j].x * v[j].x + v[j].y * v[j].y) + (v[j].z * v[j].z + v[j].w * v[j].w); }
        if (npart > 0 && isc) {
            const float* pp = (const float*)(p.ws + WS_PART) + (size_t)(row - SEQ) * DM + 4 * C.lane; ss = 0.f;
#pragma unroll
            for (int j = 0; j < 8; ++j) { f32x4 a = {0.f, 0.f, 0.f, 0.f};
                for (int k = 0; k < npart; ++k) a += *(const f32x4*)(pp + (size_t)k * 256 * DM + 256 * j);
                v[j] += *(const f32x4*)(pgate + 4 * C.lane + 256 * j) * a; ss += (v[j].x * v[j].x + v[j].y * v[j].y) + (v[j].z * v[j].z + v[j].w * v[j].w); }
            if (write_xr) { float* xr = (float*)(p.ws + WS_XR) + (size_t)row * DM;
#pragma unroll
                for (int j = 0; j < 8; ++j) *(f32x4*)(xr + 4 * C.lane + 256 * j) = v[j]; } }
        const float rstd = rsqrtf(wave_sum(ss) * (1.0f / DM) + 1e-6f);
#pragma unroll
        for (int j = 0; j < 8; ++j) { const int col = 4 * C.lane + 256 * j;
            const f32x4 w = *(const f32x4*)(normw + col), sh = *(const f32x4*)(mv + o_shift * DM + col), sc = *(const f32x4*)(mv + o_scale * DM + col);
            const f32x4 y = (v[j] * rstd) * w * (sc + 1.0f) + sh;
            u32x2 o; o.x = pk2(y.x, y.y); o.y = pk2(y.z, y.w); *(u32x2*)(XN + (size_t)row * DM + col) = o; }
    }
}

__device__ __forceinline__ void rope_cs(int pos, int i, float& cs, float& sn) {
    const float inv = exp2f(-(float)i * 0.83048202372184058696f);
    float r = ((float)pos * inv) * 0.15915494309189533577f; r = r - floorf(r);
    sn = __builtin_amdgcn_sinf(r); cs = __builtin_amdgcn_cosf(r);
}
__device__ __forceinline__ void phase_mixprep0(const Params& p, const Ctx& C) {
    const bf16_t* Z = (const bf16_t*)(p.ws + WS_Z0); bf16_t* KVN = (bf16_t*)(p.ws + WS_KVN); bf16_t* QN = (bf16_t*)(p.ws + WS_QN); bf16_t* KR = (bf16_t*)(p.ws + WS_KR); bf16_t* OA = (bf16_t*)(p.ws + WS_OA);
    const float* conv_a = p.in[8]; const float* q_norm = p.in[9]; const float* kv_norm = p.in[11];
    const int lane = C.lane;
    for (int row = C.gw; row < NTOK; row += C.NGW) {
        const bf16_t* z = Z + (size_t)row * ABN; const bool isc = row >= SEQ;
        const bool hasp = (row != 0) && (row != SEQ), hasn = (row != SEQ - 1) && (row != NTOK - 1);
        const u32x2 kvw = *(const u32x2*)(z + 4 * lane); const u32x4 qw = *(const u32x4*)(z + 320 + 8 * lane); const unsigned short krw = z[256 + lane];
        u32x4 ax[2], ab[2], acv[2], pax[2], pac[2], nax[2], nac[2];
#pragma unroll
        for (int j = 0; j < 2; ++j) { const int ch = 8 * lane + 512 * j;
            ax[j] = *(const u32x4*)(z + 832 + ch); ab[j] = *(const u32x4*)(z + 1856 + ch); acv[j] = *(const u32x4*)(z + 2880 + ch);
            pax[j] = (u32x4){0, 0, 0, 0}; pac[j] = pax[j]; nax[j] = pax[j]; nac[j] = pax[j];
            if (hasp) { pax[j] = *(const u32x4*)(z - ABN + 832 + ch); pac[j] = *(const u32x4*)(z - ABN + 2880 + ch); }
            if (hasn) { nax[j] = *(const u32x4*)(z + ABN + 832 + ch); nac[j] = *(const u32x4*)(z + ABN + 2880 + ch); } }
        {
            const u32x2 w = kvw; float a0 = blo(w.x), a1 = bhi(w.x), a2 = blo(w.y), a3 = bhi(w.y);
            const float rstd = rsqrtf(wave_sum(a0 * a0 + a1 * a1 + a2 * a2 + a3 * a3) * (1.0f / 256.f) + 1e-6f);
            const f32x4 g = *(const f32x4*)(kv_norm + 4 * lane);
            u32x2 o; o.x = pk2(a0 * rstd * g.x, a1 * rstd * g.y); o.y = pk2(a2 * rstd * g.z, a3 * rstd * g.w); *(u32x2*)(KVN + (size_t)row * 256 + 4 * lane) = o;
        }
        {
            const u32x4 w = qw; float a[8] = {blo(w.x), bhi(w.x), blo(w.y), bhi(w.y), blo(w.z), bhi(w.z), blo(w.w), bhi(w.w)};
            float ss = 0.f;
#pragma unroll
            for (int e = 0; e < 8; ++e) ss += a[e] * a[e];
            const float rstd = rsqrtf(wave_sum(ss) * (1.0f / 512.f) + 1e-6f);
            const f32x4 g0 = *(const f32x4*)(q_norm + 8 * lane), g1 = *(const f32x4*)(q_norm + 8 * lane + 4);
            u32x4 o; o.x = pk2(a[0] * rstd * g0.x, a[1] * rstd * g0.y); o.y = pk2(a[2] * rstd * g0.z, a[3] * rstd * g0.w); o.z = pk2(a[4] * rstd * g1.x, a[5] * rstd * g1.y); o.w = pk2(a[6] * rstd * g1.z, a[7] * rstd * g1.w);
            *(u32x4*)(QN + (size_t)row * 512 + 8 * lane) = o;
        }
        {
            const float x = bf2f(krw); const float xp = __shfl_xor(x, 16); const float rot = (lane & 16) ? xp : -xp;
            float cs = 1.f, sn = 0.f;
            if (!isc) rope_cs(lane < 32 ? (row >> 6) : (row & 63), lane & 15, cs, sn);
            KR[(size_t)row * 64 + lane] = (bf16_t)f2bf(x * cs + rot * sn);
        }
        {
#pragma unroll
            for (int j = 0; j < 2; ++j) { const int ch = 8 * lane + 512 * j;
                float o[8];
#pragma unroll
                for (int e = 0; e < 4; ++e) {
                    const float w0l = conv_a[ch + 2 * e], w1l = conv_a[1024 + ch + 2 * e], w2l = conv_a[2048 + ch + 2 * e];
                    const float w0h = conv_a[ch + 2 * e + 1], w1h = conv_a[1024 + ch + 2 * e + 1], w2h = conv_a[2048 + ch + 2 * e + 1];
                    o[2 * e] = blo(ab[j][e]) * (w0l * blo(pac[j][e]) * blo(pax[j][e]) + w1l * blo(acv[j][e]) * blo(ax[j][e]) + w2l * blo(nac[j][e]) * blo(nax[j][e]));
                    o[2 * e + 1] = bhi(ab[j][e]) * (w0h * bhi(pac[j][e]) * bhi(pax[j][e]) + w1h * bhi(acv[j][e]) * bhi(ax[j][e]) + w2h * bhi(nac[j][e]) * bhi(nax[j][e]));
                }
                u32x4 w; w.x = pk2(o[0], o[1]); w.y = pk2(o[2], o[3]); w.z = pk2(o[4], o[5]); w.w = pk2(o[6], o[7]);
                *(u32x4*)(OA + (size_t)row * DM + ch) = w; }
        }
    }
}

namespace attn {
constexpr int NW = 8, QBLK = 32, KVBLK = 64;
constexpr float SCALE = 0.07216878364870322f;
constexpr float THR = 8.f;
constexpr int SHM_V = KVBLK * 128 * 2, SHM_K = KVBLK * 128 * 2, SHM_KR = KVBLK * 64 * 2;
constexpr int OFF_V = 0, OFF_K = 2 * SHM_V, OFF_WS = OFF_K + 2 * SHM_K, OFF_KR = OFF_WS + NW * 64 * 4, OFF_QR = OFF_KR + 2 * SHM_KR, LDS_BYTES = OFF_QR + 256 * 128;
#define KSWZ(row, colB) ((row) * 256 + ((colB) ^ (((row) & 7) << 4)))
#define KSWZ2(row, colB) ((row) * 128 + ((colB) ^ (((row) & 7) << 4)))
#define SBAR() __builtin_amdgcn_sched_barrier(0)
__device__ __forceinline__ int crow(int r, int hi) { return (r & 3) + 8 * (r >> 2) + 4 * hi; }
__device__ __forceinline__ void partialSM(f32x16& p0, f32x16& p1, float& m_reg, float& mn, float& alpha) {
    constexpr float Cc = SCALE * 1.4426950408889634f;
    float pmax = p0[0];
#pragma unroll
    for (int r = 1; r < 16; ++r) pmax = fmaxf(pmax, p0[r]);
#pragma unroll
    for (int r = 0; r < 16; ++r) pmax = fmaxf(pmax, p1[r]);
    { auto rr = __builtin_amdgcn_permlane32_swap(__float_as_uint(pmax), __float_as_uint(pmax), false, false);
      pmax = fmaxf(__uint_as_float(rr[0]), __uint_as_float(rr[1])); }
    if (__builtin_expect(__all(pmax - m_reg <= THR / SCALE), 1)) { mn = m_reg; alpha = 1.f; }
    else { mn = fmaxf(m_reg, pmax); alpha = __builtin_amdgcn_exp2f((m_reg - mn) * Cc); m_reg = mn; }
    const float mnC = -mn * Cc;
#pragma unroll
    for (int r = 0; r < 16; ++r) p0[r] = fmaf(p0[r], Cc, mnC);
#pragma unroll
    for (int r = 0; r < 16; ++r) p1[r] = fmaf(p1[r], Cc, mnC);
#pragma unroll
    for (int r = 0; r < 16; ++r) p0[r] = __builtin_amdgcn_exp2f(p0[r]);
}
__device__ __forceinline__ void finishSM(f32x16& p0, f32x16& p1, float alpha, float& l_reg, bf16x8& pa0, bf16x8& pa1, bf16x8& pa2, bf16x8& pa3) {
#pragma unroll
    for (int r = 0; r < 16; ++r) p1[r] = __builtin_amdgcn_exp2f(p1[r]);
    float ps = 0;
#pragma unroll
    for (int r = 0; r < 16; ++r) ps += p0[r];
#pragma unroll
    for (int r = 0; r < 16; ++r) ps += p1[r];
    { auto rr = __builtin_amdgcn_permlane32_swap(__float_as_uint(ps), __float_as_uint(ps), false, false);
      ps = __uint_as_float(rr[0]) + __uint_as_float(rr[1]); }
    l_reg = l_reg * alpha + ps;
#define PK4(P, BASE, OUT) do { unsigned a0 = cvt_pk_bf16(P[BASE + 0], P[BASE + 1]), a1 = cvt_pk_bf16(P[BASE + 2], P[BASE + 3]);   \
    unsigned b0 = cvt_pk_bf16(P[BASE + 4], P[BASE + 5]), b1 = cvt_pk_bf16(P[BASE + 6], P[BASE + 7]);                              \
    auto r0 = __builtin_amdgcn_permlane32_swap(a0, b0, false, false); auto r1 = __builtin_amdgcn_permlane32_swap(a1, b1, false, false); \
    u32x4 w = {r0[0], r1[0], r0[1], r1[1]}; OUT = *reinterpret_cast<bf16x8*>(&w); } while (0)
    PK4(p0, 0, pa0); PK4(p0, 8, pa1); PK4(p1, 0, pa2); PK4(p1, 8, pa3);
#undef PK4
}
__device__ __forceinline__ void qkt(f32x16& p0, f32x16& p1, const char* Ks, const char* Krs, const char* Qrs, const bf16x8* qr, int r32, int hi, int qrow) {
    p0 = f32x16{}; p1 = f32x16{};
    asm volatile("" : "+v"(r32), "+v"(qrow));
#pragma unroll
    for (int d0 = 0; d0 < 8; ++d0) { const int cb = (d0 * 16 + hi * 8) * 2;
        const bf16x8 b0 = *reinterpret_cast<const bf16x8*>(Ks + KSWZ(r32, cb));
        const bf16x8 b1 = *reinterpret_cast<const bf16x8*>(Ks + KSWZ(32 + r32, cb));
        p0 = __builtin_amdgcn_mfma_f32_32x32x16_bf16(b0, qr[d0], p0, 0, 0, 0);
        p1 = __builtin_amdgcn_mfma_f32_32x32x16_bf16(b1, qr[d0], p1, 0, 0, 0); }
#pragma unroll
    for (int d0 = 0; d0 < 4; ++d0) { const int cb = (d0 * 16 + hi * 8) * 2;
        const bf16x8 b0 = *reinterpret_cast<const bf16x8*>(Krs + KSWZ2(r32, cb));
        const bf16x8 b1 = *reinterpret_cast<const bf16x8*>(Krs + KSWZ2(32 + r32, cb));
        const bf16x8 qf = *reinterpret_cast<const bf16x8*>(Qrs + KSWZ2(qrow, cb));
        p0 = __builtin_amdgcn_mfma_f32_32x32x16_bf16(b0, qf, p0, 0, 0, 0);
        p1 = __builtin_amdgcn_mfma_f32_32x32x16_bf16(b1, qf, p1, 0, 0, 0); }
}
__device__ __forceinline__ int v_st(int k, int c) { const int kk = (k & ~0xC) | ((k & 4) << 1) | ((k & 8) >> 1); return ((kk >> 3) * 4 + (c >> 5)) * 512 + ((kk & 7) * 32 + (c & 31)) * 2; }
__device__ __forceinline__ int v_rd_base(int lane) { return ((lane & 3) << 3) | (((lane >> 2) & 3) << 6) | (((lane >> 4) & 1) << 5) | (((lane >> 5) & 1) << 8); }
constexpr int v_rd_off(int d0, int ks, int half) { return d0 * 512 + ks * 4096 + half * 2048; }
template <int OFF> __device__ __forceinline__ s16x4 tr_read(int vb) {
    s16x4 r; asm volatile("ds_read_b64_tr_b16 %0, %1 offset:%2" : "=&v"(r) : "v"(vb), "i"(OFF) : "memory"); return r;
}
template <int D0> __device__ __forceinline__ void pv_one(f32x16& od, int vb, bf16x8 pa0, bf16x8 pa1, bf16x8 pa2, bf16x8 pa3) {
    const s16x4 l0 = tr_read<v_rd_off(D0, 0, 0)>(vb), h0 = tr_read<v_rd_off(D0, 0, 1)>(vb), l1 = tr_read<v_rd_off(D0, 1, 0)>(vb), h1 = tr_read<v_rd_off(D0, 1, 1)>(vb);
    const s16x4 l2 = tr_read<v_rd_off(D0, 2, 0)>(vb), h2 = tr_read<v_rd_off(D0, 2, 1)>(vb), l3 = tr_read<v_rd_off(D0, 3, 0)>(vb), h3 = tr_read<v_rd_off(D0, 3, 1)>(vb);
    asm volatile("s_waitcnt lgkmcnt(0)" ::: "memory"); SBAR();
#define PK(L, H) (bf16x8){L[0], L[1], L[2], L[3], H[0], H[1], H[2], H[3]}
    od = __builtin_amdgcn_mfma_f32_32x32x16_bf16(pa0, PK(l0, h0), od, 0, 0, 0);
    od = __builtin_amdgcn_mfma_f32_32x32x16_bf16(pa1, PK(l1, h1), od, 0, 0, 0);
    od = __builtin_amdgcn_mfma_f32_32x32x16_bf16(pa2, PK(l2, h2), od, 0, 0, 0);
    od = __builtin_amdgcn_mfma_f32_32x32x16_bf16(pa3, PK(l3, h3), od, 0, 0, 0);
#undef PK
}
__device__ __forceinline__ void pv_d0(f32x16* o, int vb, bf16x8 pa0, bf16x8 pa1, bf16x8 pa2, bf16x8 pa3) {
    pv_one<0>(o[0], vb, pa0, pa1, pa2, pa3); pv_one<1>(o[1], vb, pa0, pa1, pa2, pa3); pv_one<2>(o[2], vb, pa0, pa1, pa2, pa3); pv_one<3>(o[3], vb, pa0, pa1, pa2, pa3);
}

__device__ __forceinline__ void unit(const bf16_t* __restrict__ Qh, const bf16_t* __restrict__ Kh, const bf16_t* __restrict__ Vh, const bf16_t* __restrict__ KRh,
                                     bf16_t* __restrict__ Ob, int seq, int grow0, char* lds) {
    constexpr int LDQ = 1536, LDK = 2048, LDO = 2048;
    const int tid = threadIdx.x, wid = tid >> 6, lane = tid & 63, r32 = lane & 31, hi = lane >> 5;
    char* V_lds = lds + OFF_V; char* K_lds = lds + OFF_K; char* Kr_lds = lds + OFF_KR; char* Qr_lds = lds + OFF_QR;
    float* wsf = (float*)(lds + OFF_WS) + wid * 64; float* li_l = wsf; float* al_l = wsf + 32;
    float m_reg = -1e30f, l_reg = 0; f32x16 o[4] = {}; bf16x8 qr[8];
    const bf16_t* Qw = Qh + (long)(wid * QBLK + r32) * LDQ + hi * 8;
#pragma unroll
    for (int d0 = 0; d0 < 8; ++d0) qr[d0] = *reinterpret_cast<const bf16x8*>(Qw + d0 * 16);
    {
        const int row = tid >> 1, half = tid & 1; const bf16_t* qp = Qh + (long)row * LDQ + 128 + half * 32;
        u32x4 w[4];
#pragma unroll
        for (int i = 0; i < 4; ++i) w[i] = *(const u32x4*)(qp + 8 * i);
        float x[32];
#pragma unroll
        for (int i = 0; i < 4; ++i)
#pragma unroll
            for (int e = 0; e < 4; ++e) { x[8 * i + 2 * e] = blo(w[i][e]); x[8 * i + 2 * e + 1] = bhi(w[i][e]); }
        float y[32];
        const int pos = grow0 < 0 ? 0 : (half == 0 ? ((grow0 + row) >> 6) : ((grow0 + row) & 63));
#pragma unroll
        for (int i = 0; i < 16; ++i) { float cs = 1.f, sn = 0.f; if (grow0 >= 0) rope_cs(pos, i, cs, sn);
            y[i] = x[i] * cs - x[16 + i] * sn; y[16 + i] = x[16 + i] * cs + x[i] * sn; }
#pragma unroll
        for (int i = 0; i < 4; ++i) { u32x4 ov; ov.x = pk2(y[8 * i], y[8 * i + 1]); ov.y = pk2(y[8 * i + 2], y[8 * i + 3]); ov.z = pk2(y[8 * i + 4], y[8 * i + 5]); ov.w = pk2(y[8 * i + 6], y[8 * i + 7]);
            *(u32x4*)(Qr_lds + KSWZ2(row, (half * 32 + 8 * i) * 2)) = ov; }
    }
    const int qrow = wid * QBLK + r32;
    const int sr = tid >> 4, sc = (tid & 15) * 8, vst0 = v_st(sr, sc), vst1 = v_st(32 + sr, sc);
    const int krr = tid >> 3, krc = (tid & 7) * 8;
    const int vb0 = (int)(uintptr_t)V_lds + v_rd_base(lane);
    struct { bf16x8 vs0, vs1, ks0, ks1, kr; } sr_[1];
#define LD8(p) (*reinterpret_cast<const bf16x8*>(p))
    const unsigned off0 = (unsigned)(sr * LDK + sc) * 2u, off1 = off0 + 32u * LDK * 2u, offr = (unsigned)(krr * 64 + krc) * 2u;
#define SLOAD(i, k0) do { const char* vb_ = (const char*)Vh + (size_t)(k0) * (LDK * 2); const char* kb_ = (const char*)Kh + (size_t)(k0) * (LDK * 2); const char* rb_ = (const char*)KRh + (size_t)(k0) * 128; \
    sr_[i].vs0 = LD8(vb_ + off0); sr_[i].vs1 = LD8(vb_ + off1); sr_[i].ks0 = LD8(kb_ + off0); sr_[i].ks1 = LD8(kb_ + off1); sr_[i].kr = LD8(rb_ + offr); } while (0)
#define SWRITE(b, i) do { *(bf16x8*)(V_lds + (b) * SHM_V + vst0) = sr_[i].vs0;          \
    *(bf16x8*)(V_lds + (b) * SHM_V + vst1) = sr_[i].vs1; const int kc = sc * 2;               \
    *(bf16x8*)(K_lds + (b) * SHM_K + KSWZ(sr, kc)) = sr_[i].ks0;                       \
    *(bf16x8*)(K_lds + (b) * SHM_K + KSWZ(32 + sr, kc)) = sr_[i].ks1;                  \
    *(bf16x8*)(Kr_lds + (b) * SHM_KR + KSWZ2(krr, krc * 2)) = sr_[i].kr; } while (0)
#define SWAIT() asm volatile("s_waitcnt vmcnt(0)" ::: "memory")
#define RESC(a) do { if (__any((a) < 1.f)) { if (hi == 0) al_l[r32] = (a); asm volatile("s_waitcnt lgkmcnt(0)" ::: "memory"); \
    _Pragma("unroll") for (int d = 0; d < 4; ++d) _Pragma("unroll") for (int r = 0; r < 16; ++r) o[d][r] *= al_l[crow(r, hi)]; } } while (0)
    f32x16 pA0, pA1, pB0, pB1; float mnA, mnB, alA, alB; bf16x8 pa0, pa1, pa2, pa3; const int NT = seq / KVBLK;
    constexpr int SE = 0, SO = 0;
    SLOAD(SE, 0); asm volatile("s_waitcnt vmcnt(0)" ::: "memory"); SWRITE(0, SE); __syncthreads();
    qkt(pA0, pA1, K_lds, Kr_lds, Qr_lds, qr, r32, hi, qrow); partialSM(pA0, pA1, m_reg, mnA, alA);
    SLOAD(SO, KVBLK);
    SWAIT(); SWRITE(1, SO); __syncthreads();
    for (int j = 1; j + 1 < NT; j += 2) {
        SBAR(); qkt(pB0, pB1, K_lds + SHM_K, Kr_lds + SHM_KR, Qr_lds, qr, r32, hi, qrow);
        finishSM(pA0, pA1, alA, l_reg, pa0, pa1, pa2, pa3); SBAR();
        SLOAD(SO, (j + 1) * KVBLK); SBAR();
        pv_d0(o, vb0, pa0, pa1, pa2, pa3); partialSM(pB0, pB1, m_reg, mnB, alB);
        __syncthreads(); SWAIT(); SWRITE(0, SE);
        RESC(alB); __syncthreads();
        SBAR(); qkt(pA0, pA1, K_lds, Kr_lds, Qr_lds, qr, r32, hi, qrow);
        finishSM(pB0, pB1, alB, l_reg, pa0, pa1, pa2, pa3); SBAR();
        SLOAD(SE, (j + 2) * KVBLK); SBAR();
        pv_d0(o, vb0 + SHM_V, pa0, pa1, pa2, pa3); partialSM(pA0, pA1, m_reg, mnA, alA);
        __syncthreads(); SWAIT(); SWRITE(1, SO);
        RESC(alA); __syncthreads();
    }
    SBAR(); qkt(pB0, pB1, K_lds + SHM_K, Kr_lds + SHM_KR, Qr_lds, qr, r32, hi, qrow);
    finishSM(pA0, pA1, alA, l_reg, pa0, pa1, pa2, pa3); SBAR();
    pv_d0(o, vb0, pa0, pa1, pa2, pa3); partialSM(pB0, pB1, m_reg, mnB, alB);
    __syncthreads(); RESC(alB);
    finishSM(pB0, pB1, alB, l_reg, pa0, pa1, pa2, pa3); SBAR();
    pv_d0(o, vb0 + SHM_V, pa0, pa1, pa2, pa3);
    if (hi == 0) li_l[r32] = l_reg; asm volatile("s_waitcnt lgkmcnt(0)" ::: "memory");
    float rli[16];
#pragma unroll
    for (int r = 0; r < 16; ++r) rli[r] = __builtin_amdgcn_rcpf(li_l[crow(r, hi)]);
    bf16_t* Ow = Ob + (long)(wid * QBLK) * LDO;
#pragma unroll
    for (int r = 0; r < 16; ++r) { const int orow = crow(r, hi);
#pragma unroll
        for (int d0 = 0; d0 < 4; ++d0) Ow[(long)orow * LDO + d0 * 32 + r32] = (bf16_t)f2bf(o[d0][r] * rli[r]); }
#undef SLOAD
#undef SWRITE
#undef SWAIT
#undef RESC
#undef LD8
}
}

__device__ __forceinline__ void phase_attention(const Params& p, const Ctx& C, char* lds_generic) {
    const bf16_t* Q = (const bf16_t*)(p.ws + WS_Q); const bf16_t* KV = (const bf16_t*)(p.ws + WS_KV); const bf16_t* KR = (const bf16_t*)(p.ws + WS_KR); bf16_t* OA = (bf16_t*)(p.ws + WS_OA);
    for (int u = C.bid; u < 264; u += C.G) {
        int h, row0, key0, nkeys, grow0;
        if (u < 256) { h = u & 7; row0 = (u >> 3) * 256; key0 = 0; nkeys = NTOK; grow0 = row0; }
        else { h = u - 256; row0 = SEQ; key0 = SEQ; nkeys = CTX; grow0 = -1; }
        __syncthreads();
        attn::unit(Q + (size_t)row0 * 1536 + h * 192, KV + (size_t)key0 * 2048 + h * 256, KV + (size_t)key0 * 2048 + h * 256 + 128, KR + (size_t)key0 * 64,
                   OA + (size_t)row0 * DM + 1024 + h * 128, nkeys, grow0, lds_generic);
    }
    __syncthreads();
}

__device__ __forceinline__ void unpack8(const u32x4 w, float (&f)[8]) {
#pragma unroll
    for (int e = 0; e < 4; ++e) { f[2 * e] = blo(w[e]); f[2 * e + 1] = bhi(w[e]); }
}
__device__ __forceinline__ void phase_convact(const Params& p, const Ctx& C, const float* cw, const float* cb, int nrows) {
    const bf16_t* U = (const bf16_t*)(p.ws + WS_U); bf16_t* H = (bf16_t*)(p.ws + WS_H);
    const int nstrip = nrows / 16, nitems = nstrip * 704;
    for (int it = C.bid * 512 + C.tid; it < nitems; it += C.G * 512) {
        const int strip = it / 704, cgp = it % 704, r0 = strip * 16, cg0 = 8 * cgp, cv0 = DFF + 8 * cgp;
        const int lo = r0 >= SEQ ? SEQ : 0, hiE = r0 >= SEQ ? NTOK : SEQ;
        float wg[3][8], wv[3][8], bg[8], bv[8];
#pragma unroll
        for (int k = 0; k < 3; ++k)
#pragma unroll
            for (int e = 0; e < 8; ++e) { wg[k][e] = cw[k * DFF2 + cg0 + e]; wv[k][e] = cw[k * DFF2 + cv0 + e]; }
#pragma unroll
        for (int e = 0; e < 8; ++e) { bg[e] = cb[cg0 + e]; bv[e] = cb[cv0 + e]; }
        const u32x4 zero = {0, 0, 0, 0};
        u32x4 pgw = r0 > lo ? __builtin_nontemporal_load((const u32x4*)(U + (size_t)(r0 - 1) * DFF2 + cg0)) : zero, pvw = r0 > lo ? __builtin_nontemporal_load((const u32x4*)(U + (size_t)(r0 - 1) * DFF2 + cv0)) : zero;
        u32x4 cgw = __builtin_nontemporal_load((const u32x4*)(U + (size_t)r0 * DFF2 + cg0)), cvw = __builtin_nontemporal_load((const u32x4*)(U + (size_t)r0 * DFF2 + cv0));
        for (int rb = r0; rb < r0 + 16; rb += 4) {
            u32x4 ngw[4], nvw[4];
#pragma unroll
            for (int q = 0; q < 4; ++q) { const bool hn = (rb + q + 1) < hiE;
                ngw[q] = hn ? __builtin_nontemporal_load((const u32x4*)(U + (size_t)(rb + q + 1) * DFF2 + cg0)) : zero; nvw[q] = hn ? __builtin_nontemporal_load((const u32x4*)(U + (size_t)(rb + q + 1) * DFF2 + cv0)) : zero; }
#pragma unroll
            for (int q = 0; q < 4; ++q) {
                float pg[8], pv[8], cgv[8], cvv[8], ng[8], nv[8];
                unpack8(pgw, pg); unpack8(pvw, pv); unpack8(cgw, cgv); unpack8(cvw, cvv); unpack8(ngw[q], ng); unpack8(nvw[q], nv);
                float o[8];
#pragma unroll
                for (int e = 0; e < 8; ++e) { const float gsum = wg[0][e] * pg[e] + wg[1][e] * cgv[e] + wg[2][e] * ng[e] + bg[e];
                    const float vsum = wv[0][e] * pv[e] + wv[1][e] * cvv[e] + wv[2][e] * nv[e] + bv[e];
                    o[e] = silu_f(gsum) * vsum; }
                u32x4 w; w.x = pk2(o[0], o[1]); w.y = pk2(o[2], o[3]); w.z = pk2(o[4], o[5]); w.w = pk2(o[6], o[7]);
                *(u32x4*)(H + (size_t)(rb + q) * DFF + cg0) = w;
                pgw = cgw; pvw = cvw; cgw = ngw[q]; cvw = nvw[q];
            }
        }
    }
}

__device__ __forceinline__ size_t aq_off(int h, int c) { return ((size_t)(h * 32 + c) * 256) * 768; }
__device__ __forceinline__ size_t ke_off(int d, int h, int c) { return ((size_t)((d * 4 + h) * 32 + c) * 256) * 256; }
__device__ __forceinline__ size_t kdt_off(int d, int h, int c) { return ((size_t)((d * 4 + h) * NCH + c) * 256) * 256; }
__device__ __forceinline__ size_t bt4_off(int h, int c) { return ((size_t)(h * NCH + c) * 512) * 768; }
__device__ __forceinline__ size_t kvt_off(int d, int h, int c) { return ((size_t)((d * 4 + h) * NCH + c) * 512) * 256; }

__device__ __forceinline__ float logsig16(float x) { return -(fmaxf(-x, 0.f) + __logf(1.0f + __expf(-fabsf(x)))) * (1.0f / 16.0f); }

__device__ __forceinline__ void phase_gla_prep(const Params& p, const Ctx& C) {
    const bf16_t* Z = (const bf16_t*)(p.ws + WS_Z1);
    bf16_t* AQ = (bf16_t*)(p.ws + WS_AQ); bf16_t* KE = (bf16_t*)(p.ws + WS_KE); bf16_t* KDT = (bf16_t*)(p.ws + WS_KDT); bf16_t* BT4 = (bf16_t*)(p.ws + WS_BT4);
    float* DEC = (float*)(p.ws + WS_DEC);
    const float* gfw = p.in[23]; const float* gfb = p.in[24]; const float* gbw = p.in[25]; const float* gbb = p.in[26];
    LAS float* red = (LAS float*)C.lds;
    const int col = C.tid & 31, sub = C.tid >> 5;
    for (int it0 = C.bid; it0 < NCH * 32 * G1REP; it0 += C.G) { const int it = it0 % (NCH * 32);
        const int c = it >> 5, h = (it >> 3) & 3, cb = it & 7; const int j = cb * 32 + col, gc = h * 256 + j;
        float wf[16], wb[16];
#pragma unroll
        for (int r = 0; r < 16; ++r) { wf[r] = gfw[r * 1024 + gc]; wb[r] = gbw[r * 1024 + gc]; }
        const float bf_ = gfb[gc], bb_ = gbb[gc];
        const int tok0 = c * 256 + sub * 16;
        float gf[16], gb[16]; float sf = 0.f, sb = 0.f;
#pragma unroll
        for (int t = 0; t < 16; ++t) {
            const bf16_t* lr = Z + (size_t)(tok0 + t) * GLN + 6144;
            const u32x4 a0 = *(const u32x4*)(lr), a1 = *(const u32x4*)(lr + 8), b0 = *(const u32x4*)(lr + 16), b1 = *(const u32x4*)(lr + 24);
            float xf = bf_, xb = bb_;
#pragma unroll
            for (int e = 0; e < 4; ++e) {
                xf += wf[2 * e] * blo(a0[e]) + wf[2 * e + 1] * bhi(a0[e]) + wf[8 + 2 * e] * blo(a1[e]) + wf[8 + 2 * e + 1] * bhi(a1[e]);
                xb += wb[2 * e] * blo(b0[e]) + wb[2 * e + 1] * bhi(b0[e]) + wb[8 + 2 * e] * blo(b1[e]) + wb[8 + 2 * e + 1] * bhi(b1[e]); }
            gf[t] = logsig16(xf); gb[t] = logsig16(xb); sf += gf[t]; sb += gb[t];
        }
        __syncthreads();
        red[sub * 32 + col] = sf; red[512 + sub * 32 + col] = sb;
        __syncthreads();
        float offf = 0.f, totf = 0.f, offb = 0.f, totb = 0.f;
#pragma unroll
        for (int s2 = 0; s2 < 16; ++s2) { const float a = red[s2 * 32 + col], b = red[512 + s2 * 32 + col]; totf += a; totb += b; if (s2 < sub) offf += a; if (s2 > sub) offb += b; }
        if (sub == 0) { DEC[((0 * 4 + h) * NCH + c) * 256 + j] = __expf(totf); DEC[((1 * 4 + h) * NCH + c) * 256 + j] = __expf(totb); }
        float Bf = offf, pb = 0.f;
        unsigned kdf[8], kdb[8]; float kdf_lo = 0.f, kdb_lo = 0.f;
        const bool lat = c < 32;
        bf16_t* aq = AQ + (lat ? aq_off(h, c) : 0); bf16_t* kef = KE + (lat ? ke_off(0, h, c) : 0); bf16_t* keb = KE + (lat ? ke_off(1, h, c) : 0);
        {
            unsigned short q8[16], k8[16];
#pragma unroll
            for (int t = 0; t < 16; ++t) { const bf16_t* zr = Z + (size_t)(tok0 + t) * GLN; q8[t] = zr[3072 + gc]; k8[t] = zr[gc]; }
#pragma unroll
            for (int t = 0; t < 16; ++t) {
                Bf += gf[t]; const float Bb = offb + sb - pb; pb += gb[t];
                const int tl = sub * 16 + t;
                const float q = bf2f(q8[t]) * 0.0625f, k = bf2f(k8[t]);
                const float kd_f = k * __expf(totf - Bf), kd_b = k * __expf(totb - Bb);
                if (lat) {
                    aq[(size_t)tl * 768 + j] = (bf16_t)f2bf(q * __expf(Bf)); aq[(size_t)tl * 768 + 256 + j] = (bf16_t)f2bf(q * __expf(Bb));
                    kef[(size_t)tl * 256 + j] = (bf16_t)f2bf(k * __expf(-Bf)); keb[(size_t)tl * 256 + j] = (bf16_t)f2bf(k * __expf(-Bb));
                }
                if (t & 1) { kdf[t >> 1] = pk2(kdf_lo, kd_f); kdb[t >> 1] = pk2(kdb_lo, kd_b); } else { kdf_lo = kd_f; kdb_lo = kd_b; }
            }
        }
        bf16_t* kf = KDT + kdt_off(0, h, c) + (size_t)j * 256 + sub * 16; bf16_t* kb = KDT + kdt_off(1, h, c) + (size_t)j * 256 + sub * 16;
#pragma unroll
        for (int q4 = 0; q4 < 2; ++q4) { *(u32x4*)(kf + 8 * q4) = (u32x4){kdf[4 * q4], kdf[4 * q4 + 1], kdf[4 * q4 + 2], kdf[4 * q4 + 3]};
                                         *(u32x4*)(kb + 8 * q4) = (u32x4){kdb[4 * q4], kdb[4 * q4 + 1], kdb[4 * q4 + 2], kdb[4 * q4 + 3]}; }
    }
    __syncthreads();
    LAS bf16_t* tl = (LAS bf16_t*)(C.lds + 8192 + C.wave * 8448);
    for (int it0 = C.gw; it0 < NCH * 4 * 4 * 8 * G1REP; it0 += C.NGW) { const int it = it0 % (NCH * 4 * 4 * 8);
        const int dvb = it & 7, tb = (it >> 3) & 3, h = (it >> 5) & 3, c = it >> 7;
#pragma unroll
        for (int i = 0; i < 8; ++i) { const int r = i * 8 + (C.lane >> 3), ch = C.lane & 7;
            const u32x4 w = __builtin_nontemporal_load((const u32x4*)(Z + (size_t)(c * 256 + tb * 64 + r) * GLN + 1024 + h * 512 + dvb * 64 + ch * 8));
            LAS unsigned* d = (LAS unsigned*)(tl + r * 66 + ch * 8); d[0] = w.x; d[1] = w.y; d[2] = w.z; d[3] = w.w; }
        LDS_WAIT(); asm volatile("" ::: "memory");
#pragma unroll
        for (int i = 0; i < 8; ++i) { const int dv = i * 8 + (C.lane >> 3), tc = C.lane & 7;
            unsigned short e[8];
#pragma unroll
            for (int k = 0; k < 8; ++k) e[k] = tl[(tc * 8 + k) * 66 + dv];
            u32x4 w; w.x = e[0] | ((unsigned)e[1] << 16); w.y = e[2] | ((unsigned)e[3] << 16); w.z = e[4] | ((unsigned)e[5] << 16); w.w = e[6] | ((unsigned)e[7] << 16);
            *(u32x4*)(BT4 + bt4_off(h, c) + (size_t)(dvb * 64 + dv) * 768 + 512 + tb * 64 + tc * 8) = w; }
        LDS_WAIT(); asm volatile("" ::: "memory");
    }
}

struct G2aSched {
    int G, c; unsigned char* ws;
    __device__ bool next(int i, pg8::Unit& u) const {
        const int L = i * G + c; if (L >= 256) return false;
        u.id = L; const int d = L >> 7;
        u.A = (const char*)((bf16_t*)(ws + WS_AQ) + (size_t)(L & 127) * (256 * 768) + d * 256); u.B = (const char*)((bf16_t*)(ws + WS_KE) + (size_t)L * 65536); return true;
    }
    __device__ __forceinline__ void out(const pg8::Unit& u, pg8::OutInfo& o) const { o.O = (bf16_t*)(ws + WS_AT) + (size_t)u.id * 65536; o.ldc = 256; o.mask = 0; o.r0 = 0; o.c0 = 0; }
};
struct G2bSched {
    int G, c; unsigned char* ws;
    __device__ __forceinline__ static int chunk(int cp, int d) { return cp == 0 ? 32 : (d == 0 ? cp - 1 : cp); }
    __device__ bool next(int i, pg8::Unit& u) const {
        const int L = i * G + c; if (L >= 512) return false;
        u.id = L; const int mh = L & 1, hd = (L >> 1) & 7, h = hd & 3, cc = chunk(L >> 4, hd >> 2);
        u.A = (const char*)((bf16_t*)(ws + WS_BT4) + (size_t)((h * NCH + cc) * 512 + mh * 256) * 768 + 512); u.B = (const char*)((bf16_t*)(ws + WS_KDT) + (size_t)(hd * NCH + cc) * 65536); return true;
    }
    __device__ __forceinline__ void out(const pg8::Unit& u, pg8::OutInfo& o) const { const int L = u.id, mh = L & 1, hd = (L >> 1) & 7, cc = chunk(L >> 4, hd >> 2);
        o.O = (bf16_t*)(ws + WS_KVT) + (size_t)((hd * NCH + cc) * 512 + mh * 256) * 256; o.ldc = 256; o.mask = 0; o.r0 = 0; o.c0 = 0; }
};
struct G4Sched {
    int G, c; unsigned char* ws;
    __device__ bool next(int i, pg8::Unit& u) const {
        const int L0 = i * G + c; if (L0 >= 256) return false;
        const int L = (((L0 >> 4) << 3 | (L0 & 7)) << 1) | ((L0 >> 3) & 1);
        const int nh = L & 1, cc = (L >> 1) & 31, h = L >> 6; u.id = L;
        u.A = (const char*)((bf16_t*)(ws + WS_AQ) + aq_off(h, cc)); u.B = (const char*)((bf16_t*)(ws + WS_BT4) + bt4_off(h, cc) + (size_t)(nh * 256) * 768); return true;
    }
    __device__ __forceinline__ void out(const pg8::Unit& u, pg8::OutInfo& o) const {
        const int L = u.id, nh = L & 1, cc = (L >> 1) & 31, h = L >> 6;
        o.O = (bf16_t*)(ws + WS_O) + (size_t)(cc * 256) * DM + h * 512 + nh * 256; o.ldc = DM; o.mask = 0; o.r0 = L; o.c0 = 0;
    }
};

__device__ __forceinline__ void phase_gla_scan(const Params& p, const Ctx& C) {
    const bf16_t* KVT = (const bf16_t*)(p.ws + WS_KVT); const float* DEC = (const float*)(p.ws + WS_DEC); bf16_t* BT4 = (bf16_t*)(p.ws + WS_BT4);
    for (int it = C.bid * 512 + C.tid; it < 2 * 4 * 512 * 32; it += C.G * 512) {
        const int dk8 = it & 31, dv = (it >> 5) & 511, h = (it >> 14) & 3, d = it >> 16; const int dk = dk8 * 8;
        float S[8];
#pragma unroll
        for (int e = 0; e < 8; ++e) S[e] = 0.f;
        for (int s0 = 0; s0 < NCH; s0 += 3) {
            u32x4 kvw[3]; f32x4 da[3], db[3]; int cc[3];
#pragma unroll
            for (int q = 0; q < 3; ++q) { const int s = s0 + q; const int c = (s == 0) ? 32 : (d == 0 ? s - 1 : 32 - s); cc[q] = c;
                if (s < NCH - 1) { kvw[q] = __builtin_nontemporal_load((const u32x4*)(KVT + kvt_off(d, h, c) + (size_t)dv * 256 + dk));
                    const float* dc = DEC + ((d * 4 + h) * NCH + c) * 256 + dk; da[q] = *(const f32x4*)dc; db[q] = *(const f32x4*)(dc + 4); } }
#pragma unroll
            for (int q = 0; q < 3; ++q) { const int s = s0 + q; const int c = cc[q];
                if (s > 0) { u32x4 w; w.x = pk2(S[0], S[1]); w.y = pk2(S[2], S[3]); w.z = pk2(S[4], S[5]); w.w = pk2(S[6], S[7]);
                    *(u32x4*)(BT4 + bt4_off(h, c) + (size_t)dv * 768 + d * 256 + dk) = w; }
                if (s < NCH - 1) { float f[8]; unpack8(kvw[q], f); const f32x4 d0 = da[q], d1 = db[q];
                    S[0] = d0.x * S[0] + f[0]; S[1] = d0.y * S[1] + f[1]; S[2] = d0.z * S[2] + f[2]; S[3] = d0.w * S[3] + f[3];
                    S[4] = d1.x * S[4] + f[4]; S[5] = d1.y * S[5] + f[5]; S[6] = d1.z * S[6] + f[6]; S[7] = d1.w * S[7] + f[7]; } }
        }
    }
    bf16_t* AQ = (bf16_t*)(p.ws + WS_AQ); const bf16_t* AT = (const bf16_t*)(p.ws + WS_AT);
    for (int it0 = C.bid * 512 + C.tid; it0 < 128 * 256 * 32; it0 += 4 * C.G * 512) {
        u32x4 xw[4], yw[4];
#pragma unroll
        for (int q = 0; q < 4; ++q) { const int it = it0 + q * C.G * 512; if (it < 128 * 256 * 32) { const int j8 = it & 31, i = (it >> 5) & 255, hc = it >> 13;
            const bf16_t* bfw = AT + (size_t)hc * 65536 + (size_t)i * 256 + j8 * 8; xw[q] = __builtin_nontemporal_load((const u32x4*)bfw); yw[q] = __builtin_nontemporal_load((const u32x4*)(bfw + (size_t)128 * 65536)); } }
#pragma unroll
        for (int q = 0; q < 4; ++q) { const int it = it0 + q * C.G * 512; if (it < 128 * 256 * 32) { const int j8 = it & 31, i = (it >> 5) & 255, hc = it >> 13;
            float fx[8], fy[8]; unpack8(xw[q], fx); unpack8(yw[q], fy);
#pragma unroll
            for (int e = 0; e < 8; ++e) { const int j = j8 * 8 + e; fx[e] = (j <= i) ? fx[e] : 0.f; fy[e] = (j >= i) ? fy[e] : 0.f; }
            u32x4 w; w.x = pk2(fx[0] + fy[0], fx[1] + fy[1]); w.y = pk2(fx[2] + fy[2], fx[3] + fy[3]); w.z = pk2(fx[4] + fy[4], fx[5] + fy[5]); w.w = pk2(fx[6] + fy[6], fx[7] + fy[7]);
            *(u32x4*)(AQ + (size_t)hc * 256 * 768 + (size_t)i * 768 + 512 + j8 * 8) = w; } }
    }
}

__device__ __forceinline__ void phase_gla_out(const Params& p, const Ctx& C) {
    const bf16_t* O = (const bf16_t*)(p.ws + WS_O); const bf16_t* Z = (const bf16_t*)(p.ws + WS_Z1); bf16_t* OG = (bf16_t*)(p.ws + WS_OG); const float* onorm = p.in[27];
    const f32x4 g0 = *(const f32x4*)(onorm + 8 * C.lane), g1 = *(const f32x4*)(onorm + 8 * C.lane + 4);
    const float gw8[8] = {g0.x, g0.y, g0.z, g0.w, g1.x, g1.y, g1.z, g1.w};
    for (int row = C.gw; row < SEQ; row += C.NGW) {
#pragma unroll
        for (int h = 0; h < 4; ++h) {
            const u32x4 ow = *(const u32x4*)(O + (size_t)row * DM + h * 512 + 8 * C.lane), gwv = *(const u32x4*)(Z + (size_t)row * GLN + 4096 + h * 512 + 8 * C.lane);
            float o[8], g[8]; unpack8(ow, o); unpack8(gwv, g);
            float ss = 0.f;
#pragma unroll
            for (int e = 0; e < 8; ++e) ss += o[e] * o[e];
            const float rstd = rsqrtf(wave_sum(ss) * (1.0f / 512.f) + 1e-6f);
            float y[8];
#pragma unroll
            for (int e = 0; e < 8; ++e) y[e] = o[e] * rstd * gw8[e] * silu_f(g[e]);
            u32x4 w; w.x = pk2(y[0], y[1]); w.y = pk2(y[2], y[3]); w.z = pk2(y[4], y[5]); w.w = pk2(y[6], y[7]);
            *(u32x4*)(OG + (size_t)row * DM + h * 512 + 8 * C.lane) = w;
        }
    }
}

__device__ __forceinline__ void phase_final(const Params& p, const Ctx& C) {
    const float* XR = (const float*)(p.ws + WS_XR); const float* fw = p.in[34];
    for (int row = C.gw; row < SEQ; row += C.NGW) {
        const float* src = XR + (size_t)row * DM; f32x4 v[8]; float ss = 0.f;
#pragma unroll
        for (int j = 0; j < 8; ++j) { v[j] = *(const f32x4*)(src + 4 * C.lane + 256 * j); ss += (v[j].x * v[j].x + v[j].y * v[j].y) + (v[j].z * v[j].z + v[j].w * v[j].w); }
        const float rstd = rsqrtf(wave_sum(ss) * (1.0f / DM) + 1e-6f);
#pragma unroll
        for (int j = 0; j < 8; ++j) { const int col = 4 * C.lane + 256 * j; const f32x4 w = *(const f32x4*)(fw + col);
            *(f32x4*)(p.out + (size_t)row * DM + col) = (v[j] * rstd) * w; }
    }
}

#define XB_TMO      128
#define XB_XCNT(j)  (256  + 64 * (j))
#define XB_XSUB(j)  (1280 + 64 * (j))
#define XB_XGEN(j)  (2304 + 64 * (j))
#define XB_TOP      3328
#define XB_TOPGEN   3392
#define XCD_BAR_WORDS 3456
#define XB_SPIN_CAP (1u << 22)
__device__ __forceinline__ unsigned xb_ld(unsigned* p)              { return __hip_atomic_load(p, __ATOMIC_RELAXED, __HIP_MEMORY_SCOPE_AGENT); }
__device__ __forceinline__ unsigned xb_add(unsigned* p, unsigned v) { return __hip_atomic_fetch_add(p, v, __ATOMIC_RELAXED, __HIP_MEMORY_SCOPE_AGENT); }
__device__ __forceinline__ unsigned xb_xcc_id() { return (unsigned)__builtin_amdgcn_s_getreg((3 << 11) | 20) & 0xFu; }
#define XB_SPIN(cond, bar) do { unsigned _sp = 0; while (cond) { __builtin_amdgcn_s_sleep(1); \
    if ((++_sp & 255u) == 0u) { if (xb_ld(&(bar)[XB_TMO])) break; if (_sp > XB_SPIN_CAP) { atomicAdd(&(bar)[XB_TMO], 1u); break; } } } } while (0)
struct XcdBarrier { unsigned* bar; unsigned x; volatile LAS unsigned* st; };
__device__ __forceinline__ XcdBarrier xcd_barrier_post(unsigned* bar, volatile LAS unsigned* st) {
    XcdBarrier b; b.bar = bar; b.x = xb_xcc_id(); b.st = st;
    if (threadIdx.x == 0) (void)xb_add(&bar[XB_XCNT(b.x)], 1u);
    return b;
}
__device__ __forceinline__ void xcd_barrier_complete(unsigned* bar, unsigned x, unsigned& nloc, unsigned& nx) {
    const unsigned G = gridDim.x * gridDim.y * gridDim.z;
    unsigned sum, cnt, mine, sp = 0u;
    for (;;) {
        sum = 0u; cnt = 0u; mine = 0u;
#pragma unroll
        for (unsigned j = 0; j < 16; ++j) { const unsigned c = xb_ld(&bar[XB_XCNT(j)]); sum += c; cnt += (c > 0u) ? 1u : 0u; mine = (j == x) ? c : mine; }
        if (sum == G) break;
        __builtin_amdgcn_s_sleep(1);
        if ((++sp & 255u) == 0u) { if (xb_ld(&bar[XB_TMO])) break; if (sp > XB_SPIN_CAP) { atomicAdd(&bar[XB_TMO], 1u); break; } }
    }
    nloc = mine > 0u ? mine : 1u; nx = cnt > 0u ? cnt : 1u;
}
__device__ __forceinline__ void xcd_barrier(const XcdBarrier& b) {
    asm volatile("s_waitcnt vmcnt(0)" ::: "memory");
    __syncthreads();
    if (threadIdx.x == 0) {
        unsigned* bar = b.bar;
        __builtin_amdgcn_s_waitcnt(0);
        unsigned nloc = b.st[0], nx = b.st[1];
        if (nloc == 0u) { xcd_barrier_complete(bar, b.x, nloc, nx); b.st[0] = nloc; b.st[1] = nx; }
        const unsigned old = xb_add(&bar[XB_XSUB(b.x)], 1u);
        const unsigned gen = old / nloc;
        if (old + 1u == (gen + 1u) * nloc) {
            __builtin_amdgcn_fence(__ATOMIC_RELEASE, "agent");
            asm volatile("s_waitcnt vmcnt(0)" ::: "memory");
            const unsigned og = xb_add(&bar[XB_TOP], 1u);
            const unsigned tg = og / nx;
            if (og + 1u == (tg + 1u) * nx) xb_add(&bar[XB_TOPGEN], 1u);
            else XB_SPIN(xb_ld(&bar[XB_TOPGEN]) == tg, bar);
            __builtin_amdgcn_fence(__ATOMIC_ACQUIRE, "agent");
            xb_add(&bar[XB_XGEN(b.x)], 1u);
            asm volatile("s_waitcnt vmcnt(0)" ::: "memory");
        } else {
            XB_SPIN(xb_ld(&bar[XB_XGEN(b.x)]) == gen, bar);
            __builtin_amdgcn_fence(__ATOMIC_ACQUIRE, "agent");
            asm volatile("s_waitcnt vmcnt(0)" ::: "memory");
        }
    }
    __syncthreads();
}

constexpr int LDS_TOTAL = 147456;
__global__ void __launch_bounds__(512, 2) fwd_kernel(Params p) {
    extern __shared__ __attribute__((aligned(16))) unsigned char lds_raw[];
    cg::grid_group grid = cg::this_grid();
    Ctx C; C.lds = (LAS unsigned char*)lds_raw; C.tid = threadIdx.x; C.lane = C.tid & 63; C.wave = __builtin_amdgcn_readfirstlane(C.tid >> 6);
    C.G = gridDim.x; C.bid = blockIdx.x; C.gw = C.bid * 8 + C.wave; C.NGW = C.G * 8;
    unsigned char* ws = p.ws;
    const float* mod = (const float*)(ws + WS_MOD);
    float* XR = (float*)(ws + WS_XR); const bf16_t* XN = (const bf16_t*)(ws + WS_XN);
    const int lo = p.ph_lo, hi = p.ph_hi;
    volatile LAS unsigned* xst = (volatile LAS unsigned*)(C.lds + LDS_TOTAL - 64);
    if (C.tid < 2) xst[C.tid] = 0u;
    __syncthreads();
    XcdBarrier xbar = xcd_barrier_post((unsigned*)ws, xst);
    if (p.ph_hi > 1000) grid.sync();
#ifndef PH_MASK
#define PH_MASK 0xFFFFFFu
#endif
#define IN(k) ((((PH_MASK) >> (k)) & 1u) && lo <= (k) && (k) < hi)
#define RP(k) for (int rp_ = 0; rp_ < 1 + (int)(((REP_MASK) >> (k)) & 1u); ++rp_)
#define SEAM(k) do { if (IN(k) && IN((k) + 1)) { for (int br_ = 0; br_ < BAR_REP; ++br_) xcd_barrier(xbar); } } while (0)
#define GEMM_BF16(nM, nN, Ap, lda_, Bp, ldb_, Kk, Op, ldc_) do { pg8::GridSched S; S.init(nM, nN, C.G, C.bid, Ap, lda_, Bp, ldb_, Op, ldc_); S.rep = GREP; pg8::Gemm g{Kk, lda_, ldb_}; pg8::EpiBf16 E; \
        pg8::gemm_phase<pg8::EpiBf16, pg8::GridSched>(C.lds, g, S, E); } while (0)

    if (IN(0)) { phase_prologue(p, C); } SEAM(0);
    if (IN(1)) RP(1) { phase_normmod(p, C, p.in[0], p.in[2], 0, NTOK, p.in[6], 0, 0, 1, 0, nullptr, false); } SEAM(1);
    if (IN(2)) RP(2) { GEMM_BF16(33, 16, XN, DM, ws + WS_W0IN, DM, DM, (bf16_t*)(ws + WS_Z0), ABN);
                       tail_transposes(p, C, 0, 33 * 16); } SEAM(2);
    if (IN(3)) RP(3) { phase_mixprep0(p, C); } SEAM(3);
    if (IN(4)) RP(4) { GEMM_BF16(33, 6, ws + WS_QN, 512, ws + WS_W0QB, 512, 512, (bf16_t*)(ws + WS_Q), 1536);
                 GEMM_BF16(33, 8, ws + WS_KVN, 256, ws + WS_W0KVB, 256, 256, (bf16_t*)(ws + WS_KV), 2048); } SEAM(4);
    if (IN(5)) RP(5) { phase_attention(p, C, (char*)lds_raw); } SEAM(5);
    if (IN(6)) RP(6) { { pg8::GridSched S; S.init(32, 8, C.G, C.bid, ws + WS_OA, DM, ws + WS_W0OUT, DM, nullptr, 0); S.rep = P6REP; pg8::Gemm g{DM, DM, DM};
                   pg8::EpiResNorm E{p.in[0], XR, mod + 0 * NMOD + 2 * DM, p.in[14], mod + 0 * NMOD + 3 * DM, mod + 0 * NMOD + 4 * DM, (bf16_t*)(ws + WS_XN), nullptr, (float*)(ws + WS_SLOT) + (size_t)0 * 65536, (unsigned*)(ws + WS_CNT) + 0 * 2048, C.lds + pg8::STAGE_BYTES};
                   pg8::gemm_phase<pg8::EpiResNorm, pg8::GridSched>(C.lds, g, S, E); }
                 { pg8::MiniSched S{C.G, C.bid, 32, (const char*)(ws + WS_OA) + (size_t)SEQ * DM * 2, (const char*)(ws + WS_W0OUT), (size_t)256 * DM * 2}; pg8::Gemm g{512, DM, DM};
                   pg8::EpiPart E{(float*)(ws + WS_PART)};
                   pg8::gemm_phase<pg8::EpiPart, pg8::MiniSched>(C.lds, g, S, E); } } SEAM(6);
    if (IN(7)) RP(7) { phase_normmod(p, C, XR, p.in[2], SEQ, NTOK, p.in[14], 0, 3, 4, 4, mod + 1 * NMOD + 2 * DM, true); } SEAM(7);
    if (IN(8)) RP(8) { GEMM_BF16(33, 44, XN, DM, ws + WS_W0UP, DM, DM, (bf16_t*)(ws + WS_U), DFF2); tail_transposes(p, C, 1, 33 * 44); } SEAM(8);
    if (IN(9)) RP(9) { phase_convact(p, C, p.in[16], p.in[17], NTOK); } SEAM(9);
    if (IN(10)) RP(10) { { pg8::GridSched S; S.init(32, 8, C.G, C.bid, ws + WS_H, DFF, ws + WS_W0DN, DFF, nullptr, 0); pg8::Gemm g{DFF, DFF, DFF};
                    pg8::EpiResNorm E{XR, XR, mod + 0 * NMOD + 5 * DM, p.in[21], mod + 2 * NMOD + 0 * DM, mod + 2 * NMOD + 1 * DM, (bf16_t*)(ws + WS_XN), nullptr, (float*)(ws + WS_SLOT) + (size_t)1 * 65536, (unsigned*)(ws + WS_CNT) + 1 * 2048, C.lds + pg8::STAGE_BYTES};
                    pg8::gemm_phase<pg8::EpiResNorm, pg8::GridSched>(C.lds, g, S, E); }
                  { pg8::MiniSched S{C.G, C.bid, 88, (const char*)(ws + WS_H) + (size_t)SEQ * DFF * 2, (const char*)(ws + WS_W0DN), (size_t)256 * DFF * 2}; pg8::Gemm g{512, DFF, DFF};
                    pg8::EpiPart E{(float*)(ws + WS_PART)};
                    pg8::gemm_phase<pg8::EpiPart, pg8::MiniSched>(C.lds, g, S, E); } } SEAM(10);
    if (IN(11)) RP(11) { phase_normmod(p, C, XR, XR + (size_t)SEQ * DM, SEQ, NTOK, p.in[21], 1, 0, 1, 11, mod + 1 * NMOD + 5 * DM, false); } SEAM(11);
    if (IN(12)) RP(12) { GEMM_BF16(33, 25, XN, DM, ws + WS_W1IN, DM, DM, (bf16_t*)(ws + WS_Z1), GLN); tail_transposes(p, C, 2, 33 * 25); } SEAM(12);
    if (IN(13)) RP(13) { phase_gla_prep(p, C); } SEAM(13);
    if (IN(14)) RP(14) { { G2aSched S{C.G, C.bid, ws}; pg8::Gemm g{256, 768, 256}; pg8::EpiBf16 E; pg8::gemm_phase<pg8::EpiBf16, G2aSched>(C.lds, g, S, E); }
                  { G2bSched S{C.G, C.bid, ws}; pg8::Gemm g{256, 768, 256}; pg8::EpiBf16 E; pg8::gemm_phase<pg8::EpiBf16, G2bSched>(C.lds, g, S, E); } } SEAM(14);
    if (IN(15)) RP(15) { phase_gla_scan(p, C); } SEAM(15);
    if (IN(16)) RP(16) { G4Sched S{C.G, C.bid, ws}; pg8::Gemm g{768, 768, 768};
                  pg8::EpiGlaOut E{(const bf16_t*)(ws + WS_Z1), p.in[27], (bf16_t*)(ws + WS_O), (float*)(ws + WS_SLOT) + (size_t)4 * 65536, (unsigned*)(ws + WS_CNT) + 4 * 2048, C.lds + pg8::STAGE_BYTES};
                  pg8::gemm_phase<pg8::EpiGlaOut, G4Sched>(C.lds, g, S, E); } if (IN(16) && IN(18)) xcd_barrier(xbar);
    if (IN(18)) RP(18) { pg8::GridSched S; S.init(32, 8, C.G, C.bid, ws + WS_O, DM, ws + WS_W1OUT, DM, nullptr, 0); pg8::Gemm g{DM, DM, DM};
                  pg8::EpiResNorm E{XR, XR, mod + 2 * NMOD + 2 * DM, p.in[29], mod + 2 * NMOD + 3 * DM, mod + 2 * NMOD + 4 * DM, (bf16_t*)(ws + WS_XN), nullptr, (float*)(ws + WS_SLOT) + (size_t)2 * 65536, (unsigned*)(ws + WS_CNT) + 2 * 2048, C.lds + pg8::STAGE_BYTES};
                  pg8::gemm_phase<pg8::EpiResNorm, pg8::GridSched>(C.lds, g, S, E); } if (IN(18) && IN(20)) xcd_barrier(xbar);
    if (IN(20)) RP(20) { GEMM_BF16(32, 44, XN, DM, ws + WS_W1UP, DM, DM, (bf16_t*)(ws + WS_U), DFF2); } SEAM(20);
    if (IN(21)) RP(21) { phase_convact(p, C, p.in[31], p.in[32], SEQ); } SEAM(21);
    if (IN(22)) RP(22) { pg8::GridSched S; S.init(32, 8, C.G, C.bid, ws + WS_H, DFF, ws + WS_W1DN, DFF, nullptr, 0); pg8::Gemm g{DFF, DFF, DFF};
                  pg8::EpiResNorm E{XR, nullptr, mod + 2 * NMOD + 5 * DM, p.in[34], nullptr, nullptr, nullptr, p.out, (float*)(ws + WS_SLOT) + (size_t)3 * 65536, (unsigned*)(ws + WS_CNT) + 3 * 2048, C.lds + pg8::STAGE_BYTES};
                  pg8::gemm_phase<pg8::EpiResNorm, pg8::GridSched>(C.lds, g, S, E); }
#undef IN
#undef SEAM
}

extern "C" void kernel_launch(void* const* d_in, const int* in_sizes, int n_in, void* d_out, int out_size, void* d_ws, size_t ws_size, hipStream_t stream) {
    static int grid = 0;
    if (grid == 0) {
        if (n_in != 35 || ws_size < WS_END) { fprintf(stderr, "kernel_launch: unexpected n_in %d / ws_size %zu (need %zu)\n", n_in, ws_size, (size_t)WS_END); grid = -1; return; }
        int dev = 0, cus = 0, per_cu = 0;
        (void)hipGetDevice(&dev); (void)hipDeviceGetAttribute(&cus, hipDeviceAttributeMultiprocessorCount, dev);
        if (hipFuncSetAttribute((const void*)fwd_kernel, hipFuncAttributeMaxDynamicSharedMemorySize, LDS_TOTAL) != hipSuccess) { fprintf(stderr, "kernel_launch: hipFuncSetAttribute failed\n"); grid = -1; return; }
        (void)hipOccupancyMaxActiveBlocksPerMultiprocessor(&per_cu, (const void*)fwd_kernel, 512, LDS_TOTAL);
        if (per_cu < 1) { fprintf(stderr, "kernel_launch: occupancy query says %d blocks/CU\n", per_cu); per_cu = 1; }
        (void)hipGetLastError();
        grid = cus;
    }
    if (grid < 0) return;
    (void)hipMemsetAsync((char*)d_ws, 0, WS_MOD + 4 * NMOD * sizeof(float), stream);
    Params p{};
    for (int i = 0; i < 35; ++i) p.in[i] = (const float*)d_in[i];
    p.out = (float*)d_out; p.ws = (unsigned char*)d_ws;
#if N_LAUNCH_MODE == 1
    p.ph_lo = 0; p.ph_hi = NPHASE;
    void* args[] = {&p};
    hipError_t e = hipLaunchCooperativeKernel((const void*)fwd_kernel, dim3(grid), dim3(512), args, LDS_TOTAL, stream);
    if (e != hipSuccess) fprintf(stderr, "cooperative launch failed: %s (grid %d)\n", hipGetErrorString(e), grid);
#else
    for (int ph = 0; ph < NPHASE; ++ph) { p.ph_lo = ph; p.ph_hi = ph + 1; hipLaunchKernelGGL(fwd_kernel, dim3(grid), dim3(512), LDS_TOTAL, stream, p); }
#endif
}
```

```cpp
#include <hip/hip_runtime.h>
#include <hip/hip_cooperative_groups.h>
#include <cstdio>
#include <cstdint>
namespace cg = cooperative_groups;

#define LAS __attribute__((address_space(3)))
typedef unsigned short bf16_t;
typedef short bf16x8 __attribute__((ext_vector_type(8)));
typedef short s16x4 __attribute__((ext_vector_type(4)));
typedef float f32x4 __attribute__((ext_vector_type(4)));
typedef float f32x2 __attribute__((ext_vector_type(2)));
typedef float f32x16 __attribute__((ext_vector_type(16)));
typedef unsigned u32x4 __attribute__((ext_vector_type(4)));
typedef unsigned u32x2 __attribute__((ext_vector_type(2)));

#define REP_MASK 0u
#define BAR_REP 1
#define G1REP 1
#define P6REP 1
#define GREP 1
#ifndef N_LAUNCH_MODE
#define N_LAUNCH_MODE 1
#endif

constexpr int DM = 2048, SEQ = 8192, CTX = 256, NTOK = SEQ + CTX;
constexpr int NMOD = 6 * DM;
constexpr int ABN = 4096;
constexpr int GLN = 6400;
constexpr int DFF = 5632, DFF2 = 11264;
constexpr int NCH = 33;
constexpr int NPHASE = 24;

constexpr size_t MiB = 1u << 20;
constexpr size_t WS_CNT = 64 * 1024;
constexpr size_t WS_SLOT = 2 * MiB;
constexpr size_t WS_MOD = 1 * MiB;
constexpr size_t WS_DEC = 1 * MiB + 512 * 1024;
constexpr size_t WS_W0IN = 4 * MiB, WS_W0QB = 20 * MiB, WS_W0KVB = 21 * MiB + 512 * 1024, WS_W0OUT = 22 * MiB + 512 * 1024,
                 WS_W0UP = 30 * MiB + 512 * 1024, WS_W0DN = 74 * MiB + 512 * 1024;
constexpr size_t WS_KVT = 4 * MiB;
constexpr size_t WS_W1OUT = 96 * MiB + 512 * 1024, WS_W1UP = 104 * MiB + 512 * 1024, WS_W1DN = 148 * MiB + 512 * 1024;
constexpr size_t WS_XN = 171 * MiB;
constexpr size_t WS_KDT = WS_XN;
constexpr size_t WS_XR = 204 * MiB;
constexpr size_t WS_Z0 = 270 * MiB, WS_KVN = 336 * MiB, WS_QN = 341 * MiB, WS_KR = 350 * MiB, WS_Q = 352 * MiB, WS_KV = 377 * MiB, WS_OA = 410 * MiB;
constexpr size_t WS_U = 270 * MiB, WS_H = 452 * MiB;
constexpr size_t WS_Z1 = 270 * MiB, WS_AQ = 374 * MiB, WS_OG = 374 * MiB, WS_KE = 422 * MiB, WS_O = 422 * MiB, WS_BT4 = 454 * MiB, WS_W1IN = 553 * MiB;
constexpr size_t WS_PART = 578 * MiB;
constexpr size_t WS_AT = 578 * MiB;
constexpr size_t WS_END = 610 * MiB;

__device__ __forceinline__ float bf2f(unsigned v) { return __uint_as_float(v << 16); }
__device__ __forceinline__ unsigned f2bf(float f) { unsigned u = __float_as_uint(f); return (u + 0x7fffu + ((u >> 16) & 1u)) >> 16; }
__device__ __forceinline__ unsigned pk2(float lo, float hi) { return f2bf(lo) | (f2bf(hi) << 16); }
__device__ __forceinline__ unsigned cvt_pk_bf16(float lo, float hi) { unsigned r; asm volatile("v_cvt_pk_bf16_f32 %0, %1, %2" : "=v"(r) : "v"(lo), "v"(hi)); return r; }
__device__ __forceinline__ float blo(unsigned w) { return __uint_as_float(w << 16); }
__device__ __forceinline__ float bhi(unsigned w) { return __uint_as_float(w & 0xffff0000u); }
__device__ __forceinline__ float wave_sum(float v) {
#pragma unroll
    for (int o = 1; o < 64; o <<= 1) v += __shfl_xor(v, o);
    return v;
}
__device__ __forceinline__ float silu_f(float v) { return v * __builtin_amdgcn_rcpf(1.0f + __expf(-v)); }
#define LDS_WAIT() asm volatile("s_waitcnt lgkmcnt(0)" ::: "memory")

namespace pg8 {
constexpr int BM = 256, BK = 64, HALF = 128, HTB = HALF * BK * 2, STAGE_BYTES = 8 * HTB, NXCD = 8, WGM = 4;
__host__ __device__ __forceinline__ int lds_byte(int r, int c) { const int st = (r >> 4) * 2 + (c >> 5), rr = r & 15, cc = c & 31, ob = rr * 64 + cc * 2; return st * 1024 + (ob ^ (((ob >> 9) & 1) << 5)); }
__host__ __device__ __forceinline__ void stage_rc(int b, int& R, int& C) { const int st = b / 1024, sb = b % 1024, swz = sb ^ (((sb >> 9) & 1) << 5); R = (st >> 1) * 16 + swz / 64; C = (st & 1) * 32 + (swz % 64) / 2; }
__host__ __device__ __forceinline__ int perm32(int rho) { const int n = rho >> 4, i = rho & 15; return 8 * (i >> 2) + 4 * n + (i & 3); }

struct Unit { const char* A; const char* B; int id; };
struct OutInfo { bf16_t* O; int ldc, mask, r0, c0; };
struct Gemm { int K, lda, ldb; };

struct GridSched {
    int nM, nN, nwg, G, c, rep; const char* A; const char* B; size_t tA, tB; bf16_t* O; int ldc;
    __device__ void init(int nM_, int nN_, int G_, int c_, const void* A_, int lda, const void* B_, int ldb, bf16_t* O_, int ldc_) {
        nM = nM_; nN = nN_; nwg = nM * nN; G = G_; c = c_; rep = 1; A = (const char*)A_; B = (const char*)B_; tA = (size_t)BM * lda * 2; tB = (size_t)BM * ldb * 2; O = O_; ldc = ldc_; }
    __device__ bool next(int i, Unit& u) const {
        const int n_c = c < nwg ? (nwg - c + G - 1) / G : 0; if (n_c == 0 || i / n_c >= rep) return false;
        const long L = (long)(i % n_c) * G + c;
        int wgid = (int)L; { const int q = nwg / NXCD, r = nwg % NXCD, xcd = wgid % NXCD, off = wgid / NXCD; wgid = (xcd < r ? xcd * (q + 1) : r * (q + 1) + (xcd - r) * q) + off; }
        const int nig = WGM * nN, gid = wgid / nig, fm = gid * WGM, gsz = (nM - fm) < WGM ? (nM - fm) : WGM;
        const int pm = fm + ((wgid % nig) % gsz), pn = (wgid % nig) / gsz;
        u.A = A + (size_t)pm * tA; u.B = B + (size_t)pn * tB; u.id = pm | (pn << 16); return true;
    }
    __device__ __forceinline__ void out(const Unit& u, OutInfo& o) const { const int pm = u.id & 0xffff, pn = u.id >> 16;
        o.O = O + (size_t)pm * BM * ldc + (size_t)pn * BM; o.ldc = ldc; o.mask = 0; o.r0 = pm * BM; o.c0 = pn * BM; }
};

struct EpiBf16 {
    static constexpr bool PERM = true;
    __device__ __forceinline__ void operator()(const f32x4 (&acc)[2][2][4][2], const OutInfo& u, int wr, int wc, int fr, int fq) const {
        const int row0 = wr * 64 + fr, col0 = wc * 32 + 8 * fq;
#pragma unroll
        for (int ai = 0; ai < 2; ++ai)
#pragma unroll
            for (int m = 0; m < 4; ++m) { const int row = row0 + ai * HALF + m * 16; bf16_t* rowp = u.O + (size_t)row * u.ldc + col0;
#pragma unroll
                for (int bj = 0; bj < 2; ++bj) { f32x4 v0 = acc[ai][bj][m][0], v1 = acc[ai][bj][m][1];
                    u32x4 w; w.x = cvt_pk_bf16(v0[0], v0[1]); w.y = cvt_pk_bf16(v0[2], v0[3]); w.z = cvt_pk_bf16(v1[0], v1[1]); w.w = cvt_pk_bf16(v1[2], v1[3]);
                    *(u32x4*)(rowp + bj * HALF) = w; } }
    }
};
struct EpiRes {
    static constexpr bool PERM = false;
    const float* baseLat; const float* baseCtx; float* out; const float* gateLat; const float* gateCtx;
    __device__ __forceinline__ void operator()(const f32x4 (&acc)[2][2][4][2], const OutInfo& u, int wr, int wc, int fr, int fq) const {
        const bool isc = u.r0 >= SEQ; const float* base = isc ? baseCtx + (size_t)(u.r0 - SEQ) * DM : baseLat + (size_t)u.r0 * DM;
        const float* gate = isc ? gateCtx : gateLat; float* o = out + (size_t)u.r0 * DM;
        const int col0 = u.c0 + wc * 32 + 4 * fq;
        f32x4 g[2][2];
#pragma unroll
        for (int bj = 0; bj < 2; ++bj)
#pragma unroll
            for (int n = 0; n < 2; ++n) g[bj][n] = *(const f32x4*)(gate + col0 + bj * HALF + n * 16);
#pragma unroll
        for (int ai = 0; ai < 2; ++ai) {
            f32x4 pre[4][2][2];
#pragma unroll
            for (int m = 0; m < 4; ++m)
#pragma unroll
                for (int bj = 0; bj < 2; ++bj)
#pragma unroll
                    for (int n = 0; n < 2; ++n) pre[m][bj][n] = *(const f32x4*)(base + (size_t)(ai * HALF + wr * 64 + m * 16 + fr) * DM + col0 + bj * HALF + n * 16);
#pragma unroll
            for (int m = 0; m < 4; ++m)
#pragma unroll
                for (int bj = 0; bj < 2; ++bj)
#pragma unroll
                    for (int n = 0; n < 2; ++n) *(f32x4*)(o + (size_t)(ai * HALF + wr * 64 + m * 16 + fr) * DM + col0 + bj * HALF + n * 16) = pre[m][bj][n] + g[bj][n] * acc[ai][bj][m][n];
            asm volatile("" ::: "memory");
        }
    }
};
struct EpiResNorm {
    static constexpr bool PERM = true;
    const float* base; float* xr_out; const float* gate; const float* normw; const float* shift; const float* scale;
    bf16_t* xn; float* fout; float* slots; unsigned* cnt; LAS unsigned char* xl;
    __device__ __forceinline__ void operator()(f32x4 (&acc)[2][2][4][2], const OutInfo& u, int wr, int wc, int fr, int fq) const {
        int tid = threadIdx.x; asm volatile("" : "+v"(tid), "+v"(fr), "+v"(fq), "+s"(wr), "+s"(wc));
        const int lane = tid & 63, wid = tid >> 6, pm = u.r0 >> 8, pn = u.c0 >> 8;
        const size_t rbase = (size_t)u.r0 * DM; const int col0 = u.c0 + wc * 32 + 8 * fq;
        {
            const char* ub = (const char*)(base + rbase); char* uo = (char*)(xr_out ? xr_out + rbase : nullptr);
            unsigned lo0 = (unsigned)((wr * 64 + fr) * DM + col0) * 4u;
            f32x4 g[2][2];
#pragma unroll
            for (int bj = 0; bj < 2; ++bj)
#pragma unroll
                for (int n = 0; n < 2; ++n) g[bj][n] = *(const f32x4*)(gate + col0 + bj * HALF + n * 4);
#pragma unroll
            for (int ai = 0; ai < 2; ++ai) {
                f32x4 pre[4][2][2];
#pragma unroll
                for (int m = 0; m < 4; ++m)
#pragma unroll
                    for (int bj = 0; bj < 2; ++bj)
#pragma unroll
                        for (int n = 0; n < 2; ++n) pre[m][bj][n] = __builtin_nontemporal_load((const f32x4*)(ub + lo0 + (unsigned)(((ai * HALF + m * 16) * DM + bj * HALF + n * 4) * 4)));
#pragma unroll
                for (int m = 0; m < 4; ++m)
#pragma unroll
                    for (int bj = 0; bj < 2; ++bj)
#pragma unroll
                        for (int n = 0; n < 2; ++n) { acc[ai][bj][m][n] = pre[m][bj][n] + g[bj][n] * acc[ai][bj][m][n];
                            if (xr_out) *(f32x4*)(uo + lo0 + (unsigned)(((ai * HALF + m * 16) * DM + bj * HALF + n * 4) * 4)) = acc[ai][bj][m][n]; }
#pragma unroll
                for (int m = 0; m < 4; ++m) asm volatile("" : "+v"(acc[ai][0][m][0]), "+v"(acc[ai][0][m][1]), "+v"(acc[ai][1][m][0]), "+v"(acc[ai][1][m][1]), "+v"(lo0) :: "memory");
            }
        }
        LAS float* P = (LAS float*)xl;
        LAS float* Sr = (LAS float*)(xl + 4096);
        LAS unsigned* flag = (LAS unsigned*)(xl + 4096 + 1024);
#pragma unroll
        for (int ai = 0; ai < 2; ++ai)
#pragma unroll
            for (int m = 0; m < 4; ++m) { float sq = 0.f;
#pragma unroll
                for (int bj = 0; bj < 2; ++bj)
#pragma unroll
                    for (int n = 0; n < 2; ++n) { const f32x4 x = acc[ai][bj][m][n]; sq += (x[0] * x[0] + x[1] * x[1]) + (x[2] * x[2] + x[3] * x[3]); }
                sq += __shfl_xor(sq, 16); sq += __shfl_xor(sq, 32);
                if (fq == 0) P[(ai * HALF + wr * 64 + m * 16 + fr) * 4 + wc] = sq; }
        asm volatile("s_waitcnt lgkmcnt(0)" ::: "memory"); __builtin_amdgcn_s_barrier(); asm volatile("" ::: "memory");
        if (tid < 256) { const float tot = (P[tid * 4 + 0] + P[tid * 4 + 1]) + (P[tid * 4 + 2] + P[tid * 4 + 3]);
            __hip_atomic_store(slots + ((size_t)(pm * 256 + tid) * 8 + pn), tot, __ATOMIC_RELAXED, __HIP_MEMORY_SCOPE_AGENT); }
        asm volatile("s_waitcnt vmcnt(0)" ::: "memory");
        if (wid < 4 && lane == 0) __hip_atomic_fetch_add(cnt + 64 * pm, 1u, __ATOMIC_RELAXED, __HIP_MEMORY_SCOPE_AGENT);
        if (wid == 0) {
            unsigned sp = 0; bool dead = false;
            while ((unsigned)__builtin_amdgcn_readfirstlane(__hip_atomic_load(cnt + 64 * pm, __ATOMIC_RELAXED, __HIP_MEMORY_SCOPE_AGENT)) < 32u) {
                __builtin_amdgcn_s_sleep(2); if (++sp > (1u << 24)) { dead = true; break; } }
            __builtin_amdgcn_fence(__ATOMIC_ACQUIRE, "agent");
            if (lane == 0) flag[0] = dead ? 1u : 0u;
        }
        asm volatile("s_waitcnt vmcnt(0) lgkmcnt(0)" ::: "memory"); __builtin_amdgcn_s_barrier(); asm volatile("" ::: "memory");
        if (tid < 256) { const float* sl = slots + (size_t)(pm * 256 + tid) * 8; float tot = 0.f;
#pragma unroll
            for (int t = 0; t < 8; ++t) tot += __hip_atomic_load(sl + t, __ATOMIC_RELAXED, __HIP_MEMORY_SCOPE_AGENT);
            float r = rsqrtf(tot * (1.0f / DM) + 1e-6f); if (flag[0]) r = __builtin_nanf("");
            Sr[tid] = r; }
        asm volatile("s_waitcnt lgkmcnt(0)" ::: "memory"); __builtin_amdgcn_s_barrier(); asm volatile("" ::: "memory");
#pragma unroll
        for (int bj = 0; bj < 2; ++bj) { const int col = col0 + bj * HALF;
            f32x4 w0 = *(const f32x4*)(normw + col), w1 = *(const f32x4*)(normw + col + 4), s0 = {0.f, 0.f, 0.f, 0.f}, s1 = s0;
            if (shift) { w0 = w0 * (*(const f32x4*)(scale + col) + 1.0f); w1 = w1 * (*(const f32x4*)(scale + col + 4) + 1.0f); s0 = *(const f32x4*)(shift + col); s1 = *(const f32x4*)(shift + col + 4); }
#pragma unroll
            for (int ai = 0; ai < 2; ++ai)
#pragma unroll
                for (int m = 0; m < 4; ++m) { const int rl = ai * HALF + wr * 64 + m * 16 + fr; const float rs = Sr[rl];
                    const f32x4 y0 = (acc[ai][bj][m][0] * rs) * w0 + s0, y1 = (acc[ai][bj][m][1] * rs) * w1 + s1;
                    if (fout) { *(f32x4*)(fout + rbase + (size_t)rl * DM + col) = y0; *(f32x4*)(fout + rbase + (size_t)rl * DM + col + 4) = y1; }
                    else { u32x4 o; o.x = cvt_pk_bf16(y0[0], y0[1]); o.y = cvt_pk_bf16(y0[2], y0[3]); o.z = cvt_pk_bf16(y1[0], y1[1]); o.w = cvt_pk_bf16(y1[2], y1[3]); *(u32x4*)(xn + rbase + (size_t)rl * DM + col) = o; } } }
        asm volatile("s_waitcnt lgkmcnt(0)" ::: "memory"); __builtin_amdgcn_s_barrier(); asm volatile("" ::: "memory");
    }
};
struct EpiGlaOut {
    static constexpr bool PERM = true;
    const bf16_t* Z; const float* onorm; bf16_t* og; float* slots; unsigned* cnt; LAS unsigned char* xl;
    __device__ __forceinline__ void operator()(f32x4 (&acc)[2][2][4][2], const OutInfo& u, int wr, int wc, int fr, int fq) const {
        int tid = threadIdx.x; asm volatile("" : "+v"(tid), "+v"(fr), "+v"(fq), "+s"(wr), "+s"(wc));
        const int lane = tid & 63, wid = tid >> 6, L = u.r0, nh = L & 1, cc = (L >> 1) & 31, h = L >> 6, pair = L >> 1;
        LAS float* P = (LAS float*)xl; LAS float* Sr = (LAS float*)(xl + 4096); LAS unsigned* flag = (LAS unsigned*)(xl + 4096 + 1024);
#pragma unroll
        for (int ai = 0; ai < 2; ++ai)
#pragma unroll
            for (int m = 0; m < 4; ++m) { float sq = 0.f;
#pragma unroll
                for (int bj = 0; bj < 2; ++bj)
#pragma unroll
                    for (int n = 0; n < 2; ++n) { const f32x4 x = acc[ai][bj][m][n]; sq += (x[0] * x[0] + x[1] * x[1]) + (x[2] * x[2] + x[3] * x[3]); }
                sq += __shfl_xor(sq, 16); sq += __shfl_xor(sq, 32);
                if (fq == 0) P[(ai * HALF + wr * 64 + m * 16 + fr) * 4 + wc] = sq; }
        asm volatile("s_waitcnt lgkmcnt(0)" ::: "memory"); __builtin_amdgcn_s_barrier(); asm volatile("" ::: "memory");
        if (tid < 256) { const float tot = (P[tid * 4 + 0] + P[tid * 4 + 1]) + (P[tid * 4 + 2] + P[tid * 4 + 3]);
            __hip_atomic_store(slots + ((size_t)(pair * 256 + tid) * 2 + nh), tot, __ATOMIC_RELAXED, __HIP_MEMORY_SCOPE_AGENT); }
        asm volatile("s_waitcnt vmcnt(0)" ::: "memory");
        if (wid < 4 && lane == 0) __hip_atomic_fetch_add(cnt + 64 * pair, 1u, __ATOMIC_RELAXED, __HIP_MEMORY_SCOPE_AGENT);
        if (wid == 0) {
            unsigned sp = 0; bool dead = false;
            while ((unsigned)__builtin_amdgcn_readfirstlane(__hip_atomic_load(cnt + 64 * pair, __ATOMIC_RELAXED, __HIP_MEMORY_SCOPE_AGENT)) < 8u) {
                __builtin_amdgcn_s_sleep(2); if (++sp > (1u << 24)) { dead = true; break; } }
            __builtin_amdgcn_fence(__ATOMIC_ACQUIRE, "agent");
            if (lane == 0) flag[0] = dead ? 1u : 0u;
        }
        asm volatile("s_waitcnt vmcnt(0) lgkmcnt(0)" ::: "memory"); __builtin_amdgcn_s_barrier(); asm volatile("" ::: "memory");
        if (tid < 256) { const float* sl = slots + (size_t)(pair * 256 + tid) * 2;
            const float tot = __hip_atomic_load(sl, __ATOMIC_RELAXED, __HIP_MEMORY_SCOPE_AGENT) + __hip_atomic_load(sl + 1, __ATOMIC_RELAXED, __HIP_MEMORY_SCOPE_AGENT);
            float r = rsqrtf(tot * (1.0f / 512.f) + 1e-6f); if (flag[0]) r = __builtin_nanf("");
            Sr[tid] = r; }
        asm volatile("s_waitcnt lgkmcnt(0)" ::: "memory"); __builtin_amdgcn_s_barrier(); asm volatile("" ::: "memory");
        const int dv0 = nh * 256 + wc * 32 + 8 * fq; const size_t tok0 = (size_t)cc * 256;
#pragma unroll
        for (int bj = 0; bj < 2; ++bj) { const int dv = dv0 + bj * HALF; const f32x4 w0 = *(const f32x4*)(onorm + dv), w1 = *(const f32x4*)(onorm + dv + 4);
#pragma unroll
            for (int ai = 0; ai < 2; ++ai) {
                u32x4 gw[4];
#pragma unroll
                for (int m = 0; m < 4; ++m) gw[m] = __builtin_nontemporal_load((const u32x4*)(Z + (tok0 + ai * HALF + wr * 64 + m * 16 + fr) * GLN + 4096 + h * 512 + dv));
#pragma unroll
                for (int m = 0; m < 4; ++m) { const int rl = ai * HALF + wr * 64 + m * 16 + fr; const float rs = Sr[rl];
                    const f32x4 y0 = (acc[ai][bj][m][0] * rs) * w0, y1 = (acc[ai][bj][m][1] * rs) * w1;
                    u32x4 o; o.x = cvt_pk_bf16(y0[0] * silu_f(blo(gw[m].x)), y0[1] * silu_f(bhi(gw[m].x))); o.y = cvt_pk_bf16(y0[2] * silu_f(blo(gw[m].y)), y0[3] * silu_f(bhi(gw[m].y)));
                    o.z = cvt_pk_bf16(y1[0] * silu_f(blo(gw[m].z)), y1[1] * silu_f(bhi(gw[m].z))); o.w = cvt_pk_bf16(y1[2] * silu_f(blo(gw[m].w)), y1[3] * silu_f(bhi(gw[m].w)));
                    *(u32x4*)(og + (tok0 + rl) * DM + h * 512 + dv) = o; } } }
        asm volatile("s_waitcnt lgkmcnt(0)" ::: "memory"); __builtin_amdgcn_s_barrier(); asm volatile("" ::: "memory");
    }
};
struct EpiPart {
    static constexpr bool PERM = false;
    float* part;
    __device__ __forceinline__ void operator()(const f32x4 (&acc)[2][2][4][2], const OutInfo& u, int wr, int wc, int fr, int fq) const {
        float* o = part + (size_t)u.r0 * DM; const int col0 = u.c0 + wc * 32 + 4 * fq;
#pragma unroll
        for (int bj = 0; bj < 2; ++bj)
#pragma unroll
            for (int n = 0; n < 2; ++n) { const int col = col0 + bj * HALF + n * 16;
#pragma unroll
                for (int ai = 0; ai < 2; ++ai)
#pragma unroll
                    for (int m = 0; m < 4; ++m) *(f32x4*)(o + (size_t)(ai * HALF + wr * 64 + m * 16 + fr) * DM + col) = acc[ai][bj][m][n]; }
    }
};
struct MiniSched {
    int G, c, n; const char* A; const char* B; size_t tB;
    __device__ bool next(int i, Unit& u) const { const int L = i * G + c; if (L >= n) return false; u.id = L;
        u.A = A + (size_t)(L >> 3) * 1024; u.B = B + (size_t)(L & 7) * tB + (size_t)(L >> 3) * 1024; return true; }
    __device__ __forceinline__ void out(const Unit& u, OutInfo& o) const { o.O = nullptr; o.ldc = 0; o.mask = 0; o.r0 = (u.id >> 3) * BM; o.c0 = (u.id & 7) * BM; }
};

template <class Epi, class Sched>
__device__ __forceinline__ void gemm_phase(LAS unsigned char* lds, const Gemm g, const Sched& S, const Epi& E) {
    const int tid = threadIdx.x, wid = __builtin_amdgcn_readfirstlane(tid >> 6), lane = tid & 63, wr = wid >> 2, wc = wid & 3, fr = lane & 15, fq = lane >> 4;
    int K = g.K; asm volatile("" : "+s"(K)); const int nt = K / BK;
    unsigned voffA[2], voffB[2];
#pragma unroll
    for (int i = 0; i < 2; ++i) { int R, C; stage_rc(tid * 16 + i * 8192, R, C); const int Rb = Epi::PERM ? ((R & ~31) + perm32(R & 31)) : R;
        voffA[i] = (unsigned)(R * g.lda + C) * 2u; voffB[i] = (unsigned)(Rb * g.ldb + C) * 2u; }
    const size_t kstep = (size_t)(BK * 2);
    const size_t hstepA = (size_t)HALF * g.lda * 2, hstepB = (size_t)HALF * g.ldb * 2;
    const unsigned ldsw = (unsigned)wid * 1024u;
    const int aoff = lds_byte(wr * 64 + fr, fq * 8), boff = lds_byte(wc * 32 + fr, fq * 8);
#define PG8_SA(b, h) (((b) * 2 + (h)) * HTB)
#define PG8_SB(b, h) ((4 + (b) * 2 + (h)) * HTB)
#define PG8_STAGE(bufoff, gbase, voff) do { _Pragma("unroll") for (int _i = 0; _i < 2; ++_i) \
        __builtin_amdgcn_global_load_lds((const unsigned*)((const char*)(gbase) + (voff)[_i]), (LAS unsigned*)(lds + (bufoff) + ldsw + _i * 8192), 16, 0, 0); } while (0)
#define PG8_LDA(dst, b, h) do { _Pragma("unroll") for (int m = 0; m < 4; ++m) _Pragma("unroll") for (int k = 0; k < 2; ++k) dst[m][k] = *(const LAS bf16x8*)(lds + PG8_SA(b, h) + aoff + m * 2048 + k * 1024); } while (0)
#define PG8_LDB(dst, b, h) do { _Pragma("unroll") for (int n = 0; n < 2; ++n) _Pragma("unroll") for (int k = 0; k < 2; ++k) dst[n][k] = *(const LAS bf16x8*)(lds + PG8_SB(b, h) + boff + n * 2048 + k * 1024); } while (0)
#define PG8_MMA(ai, bj, At, Bt) do { __builtin_amdgcn_s_setprio(1); _Pragma("unroll") for (int m = 0; m < 4; ++m) _Pragma("unroll") for (int n = 0; n < 2; ++n) _Pragma("unroll") for (int k = 0; k < 2; ++k) \
        acc[ai][bj][m][n] = __builtin_amdgcn_mfma_f32_16x16x32_bf16(Bt[n][k], At[m][k], acc[ai][bj][m][n], 0, 0, 0); __builtin_amdgcn_s_setprio(0); } while (0)
#define PG8_WAIT_V(n) asm volatile("s_waitcnt vmcnt(" #n ")" ::: "memory")
#define PG8_WAIT_L(n) asm volatile("s_waitcnt lgkmcnt(" #n ")" ::: "memory")
#define PG8_BAR __builtin_amdgcn_s_barrier()
#define PG8_SCHED __builtin_amdgcn_sched_barrier(0)
    Unit cur, nxt; int ui = 0;
    if (!S.next(0, cur)) return;
    f32x4 acc[2][2][4][2];
#pragma unroll
    for (int a = 0; a < 2; ++a)
#pragma unroll
        for (int b = 0; b < 2; ++b)
#pragma unroll
            for (int m = 0; m < 4; ++m)
#pragma unroll
                for (int n = 0; n < 2; ++n) acc[a][b][m][n] = (f32x4){0.f, 0.f, 0.f, 0.f};
    bf16x8 At[4][2], B0[2][2], B1[2][2];
    const char* cA = cur.A; const char* cB = cur.B;
    PG8_STAGE(PG8_SB(0, 0), cB, voffB); PG8_STAGE(PG8_SB(0, 1), cB + hstepB, voffB); PG8_STAGE(PG8_SA(0, 0), cA, voffA); PG8_STAGE(PG8_SA(0, 1), cA + hstepA, voffA);
    if (wr == 1) PG8_BAR;
    PG8_WAIT_V(2); PG8_BAR;
    PG8_STAGE(PG8_SB(1, 0), cB + kstep, voffB); PG8_STAGE(PG8_SA(1, 0), cA + kstep, voffA); PG8_STAGE(PG8_SB(1, 1), cB + hstepB + kstep, voffB);
    PG8_WAIT_V(6); PG8_BAR;
    for (;;) {
        const bool has_next = S.next(ui + 1, nxt);
        const char* nA = has_next ? nxt.A : cA; const char* nB = has_next ? nxt.B : cB;
        for (int t = 0; t < nt; t += 2) {
            const bool last = (t == nt - 2);
            const char* a1 = cA + (size_t)(t + 1) * kstep;
            const char* a2 = last ? nA : cA + (size_t)(t + 2) * kstep; const char* b2 = last ? nB : cB + (size_t)(t + 2) * kstep;
            const char* a3 = a2 + kstep; const char* b3 = b2 + kstep;
            PG8_LDB(B0, 0, 0); PG8_LDB(B1, 0, 1); PG8_SCHED; PG8_LDA(At, 0, 0); PG8_STAGE(PG8_SA(1, 1), a1 + hstepA, voffA);
            PG8_WAIT_V(8); PG8_WAIT_L(0); PG8_BAR; PG8_MMA(0, 0, At, B0); PG8_MMA(0, 1, At, B1); PG8_BAR; PG8_SCHED;
            PG8_LDA(At, 0, 1); PG8_STAGE(PG8_SB(0, 0), b2, voffB); PG8_STAGE(PG8_SB(0, 1), b2 + hstepB, voffB); PG8_STAGE(PG8_SA(0, 0), a2, voffA);
            PG8_WAIT_V(8); PG8_WAIT_L(0); PG8_BAR; PG8_MMA(1, 0, At, B0); PG8_MMA(1, 1, At, B1); PG8_BAR; PG8_SCHED;
            PG8_LDB(B0, 1, 0); PG8_LDB(B1, 1, 1); PG8_SCHED; PG8_LDA(At, 1, 0); PG8_STAGE(PG8_SA(0, 1), a2 + hstepA, voffA);
            PG8_WAIT_V(8); PG8_WAIT_L(0); PG8_BAR; PG8_MMA(0, 0, At, B0); PG8_MMA(0, 1, At, B1); PG8_BAR; PG8_SCHED;
            PG8_LDA(At, 1, 1); PG8_STAGE(PG8_SB(1, 0), b3, voffB); PG8_STAGE(PG8_SB(1, 1), b3 + hstepB, voffB); PG8_STAGE(PG8_SA(1, 0), a3, voffA);
            PG8_WAIT_V(8); PG8_WAIT_L(0); PG8_BAR; PG8_MMA(1, 0, At, B0); PG8_MMA(1, 1, At, B1); PG8_BAR; PG8_SCHED;
        }
        if (wr == 0) PG8_BAR;
        { OutInfo oi; S.out(cur, oi); E(acc, oi, wr, wc, fr, fq); }
        if (!has_next) break;
#pragma unroll
        for (int a = 0; a < 2; ++a)
#pragma unroll
            for (int b = 0; b < 2; ++b)
#pragma unroll
                for (int m = 0; m < 4; ++m)
#pragma unroll
                    for (int n = 0; n < 2; ++n) acc[a][b][m][n] = (f32x4){0.f, 0.f, 0.f, 0.f};
        cur = nxt; cA = nA; cB = nB; ++ui;
        if (wr == 1) PG8_BAR;
    }
    PG8_WAIT_V(0);
    PG8_BAR;
#undef PG8_SA
#undef PG8_SB
#undef PG8_STAGE
#undef PG8_LDA
#undef PG8_LDB
#undef PG8_MMA
#undef PG8_WAIT_V
#undef PG8_WAIT_L
#undef PG8_BAR
#undef PG8_SCHED
}
}

struct Params {
    const float* in[35];
    float* out;
    unsigned char* ws;
    int ph_lo, ph_hi;
};

struct Ctx {
    LAS unsigned char* lds;
    int tid, lane, wave, G, bid, gw, NGW;
};

__device__ __forceinline__ void transpose_item(const float* W, int K, int N, bf16_t* WT, int mode, LAS float* scr, int item, int lane) {
    const int nblk = N / 32, kb = item / nblk, nb = item % nblk, k0 = 64 * kb, n0 = 32 * nb;
    int d0 = n0;
    if (mode == 1) d0 = (n0 < 3072) ? n0 : (n0 < 3104 ? n0 + 3072 : n0 - 32);
#pragma unroll 8
    for (int i = 0; i < 32; ++i) { const int kk = 2 * i + (lane >> 5); scr[kk * 33 + (lane & 31)] = __builtin_nontemporal_load(W + (size_t)(k0 + kk) * N + n0 + (lane & 31)); }
    LDS_WAIT(); asm volatile("" ::: "memory");
    const int c = lane & 7;
#pragma unroll
    for (int j = 0; j < 4; ++j) { const int n = (lane >> 3) + 8 * j; const LAS float* s = scr + (8 * c) * 33 + n;
        u32x4 o; o.x = pk2(s[0 * 33], s[1 * 33]); o.y = pk2(s[2 * 33], s[3 * 33]); o.z = pk2(s[4 * 33], s[5 * 33]); o.w = pk2(s[6 * 33], s[7 * 33]);
        *(u32x4*)(WT + (size_t)(d0 + n) * K + k0 + 8 * c) = o; }
    LDS_WAIT(); asm volatile("" ::: "memory");
}

__device__ __forceinline__ void transpose_item64(const float* W, int K, int N, bf16_t* WT, LAS float* scr, int item, int lane) {
    const int nblk = N / 64, kb = item / nblk, nb = item % nblk, k0 = 64 * kb, n0 = 64 * nb;
    const int lr = lane >> 4, lc = 4 * (lane & 15);
#pragma unroll 8
    for (int i = 0; i < 16; ++i) { const int kk = 4 * i + lr; const f32x4 v = __builtin_nontemporal_load((const f32x4*)(W + (size_t)(k0 + kk) * N + n0 + lc));
        LAS float* d = scr + kk * 65 + lc; d[0] = v.x; d[1] = v.y; d[2] = v.z; d[3] = v.w; }
    LDS_WAIT(); asm volatile("" ::: "memory");
    const int c = lane & 7;
#pragma unroll
    for (int j = 0; j < 8; ++j) { const int n = (lane >> 3) + 8 * j; const LAS float* s = scr + (8 * c) * 65 + n;
        u32x4 o; o.x = pk2(s[0 * 65], s[1 * 65]); o.y = pk2(s[2 * 65], s[3 * 65]); o.z = pk2(s[4 * 65], s[5 * 65]); o.w = pk2(s[6 * 65], s[7 * 65]);
        *(u32x4*)(WT + (size_t)(n0 + n) * K + k0 + 8 * c) = o; }
    LDS_WAIT(); asm volatile("" ::: "memory");
}

__device__ __forceinline__ void phase_prologue(const Params& p, const Ctx& C) {
    LAS float* scr = (LAS float*)(C.lds + C.wave * 16640);
    unsigned char* ws = p.ws;
    constexpr int I0 = 32 * 61, I1 = 8 * 24, I2 = 4 * 32, I3 = 32 * 32, I4 = 32 * 176;
    constexpr int NIT = I0 + I1 + I2 + I3 + I4;
    for (int rp_ = 0; rp_ < 1 + (int)((REP_MASK) & 1u); ++rp_)
    for (int it = C.gw; it < NIT; it += C.NGW) {
        int r = it;
        if (r < I0) { transpose_item64(p.in[7], 2048, 3904, (bf16_t*)(ws + WS_W0IN), scr, r, C.lane); continue; } r -= I0;
        if (r < I1) { transpose_item64(p.in[10], 512, 1536, (bf16_t*)(ws + WS_W0QB), scr, r, C.lane); continue; } r -= I1;
        if (r < I2) { transpose_item64(p.in[12], 256, 2048, (bf16_t*)(ws + WS_W0KVB), scr, r, C.lane); continue; } r -= I2;
        if (r < I3) { transpose_item64(p.in[13], 2048, 2048, (bf16_t*)(ws + WS_W0OUT), scr, r, C.lane); continue; } r -= I3;
        transpose_item64(p.in[15], 2048, DFF2, (bf16_t*)(ws + WS_W0UP), scr, r, C.lane);
    }
    float* mod = (float*)(ws + WS_MOD);
    for (int it = C.gw; it < 1536; it += C.NGW) {
        const int L = it / 768, r = it % 768, kc = r / 48, ng = r % 48;
        const float* W = L ? p.in[19] : p.in[4]; const float* bias = L ? p.in[20] : p.in[5];
        const int n = ng * 256 + C.lane * 4, k0 = kc * 128;
        f32x4 ac = {0.f, 0.f, 0.f, 0.f}, ax = {0.f, 0.f, 0.f, 0.f};
        for (int half = 0; half < 2; ++half) {
            const float cv = p.in[1][k0 + half * 64 + C.lane], xv = p.in[3][k0 + half * 64 + C.lane];
            const float av = silu_f(cv), bv = silu_f(xv);
            const float* Wr = W + (size_t)(k0 + half * 64) * NMOD + n;
#pragma unroll 8
            for (int kk = 0; kk < 64; ++kk) { const float a = __shfl(av, kk), b = __shfl(bv, kk); const f32x4 w = __builtin_nontemporal_load((const f32x4*)(Wr + (size_t)kk * NMOD)); ac += a * w; ax += b * w; }
        }
        if (kc == 0) { const f32x4 b4 = *(const f32x4*)(bias + n); ac += b4; ax += b4; }
        float* m0 = mod + (size_t)(L * 2 + 0) * NMOD + n; float* m1 = mod + (size_t)(L * 2 + 1) * NMOD + n;
#pragma unroll
        for (int j = 0; j < 4; ++j) { atomicAdd(m0 + j, ac[j]); atomicAdd(m1 + j, ax[j]); }
    }
}

__device__ __forceinline__ void tail_transposes(const Params& p, const Ctx& C, int set, int nunits) {
    const int rounds = (nunits + C.G - 1) / C.G, nfull = nunits - (rounds - 1) * C.G;
    int wg = C.bid, nwg = C.G;
    if (nfull > 0 && nfull < C.G) { if (C.bid < nfull) return; wg = C.bid - nfull; nwg = C.G - nfull; }
    LAS float* scr = (LAS float*)(C.lds + C.wave * 16640);
    unsigned char* ws = p.ws;
    constexpr int I3 = 32 * 32, I4 = 32 * 176, I5 = 88 * 32, I6 = 32 * 193;
    const int NIT = set == 0 ? I6 : (set == 1 ? I5 : I3 + I4 + I5);
    for (int it = wg * 8 + C.wave; it < NIT; it += nwg * 8) {
        int r = it;
        if (set == 0) { transpose_item(p.in[22], 2048, 6176, (bf16_t*)(ws + WS_W1IN), 1, scr, r, C.lane); continue; }
        if (set == 1) { transpose_item64(p.in[18], DFF, 2048, (bf16_t*)(ws + WS_W0DN), scr, r, C.lane); continue; }
        if (r < I3) { transpose_item64(p.in[28], 2048, 2048, (bf16_t*)(ws + WS_W1OUT), scr, r, C.lane); continue; } r -= I3;
        if (r < I4) { transpose_item64(p.in[30], 2048, DFF2, (bf16_t*)(ws + WS_W1UP), scr, r, C.lane); continue; } r -= I4;
        transpose_item64(p.in[33], DFF, 2048, (bf16_t*)(ws + WS_W1DN), scr, r, C.lane);
    }
}

__device__ __forceinline__ void phase_normmod(const Params& p, const Ctx& C, const float* srcLat, const float* srcCtx, int row_lo, int nrows, const float* normw, int L, int o_shift, int o_scale, int npart, const float* pgate, bool write_xr) {
    bf16_t* XN = (bf16_t*)(p.ws + WS_XN); const float* mod = (const float*)(p.ws + WS_MOD);
#define NMC(j) (8 * C.lane + 512 * ((j) >> 1) + 4 * ((j) & 1))
    for (int row = row_lo + C.gw; row < nrows; row += C.NGW) {
        const bool isc = row >= SEQ; const float* src = isc ? srcCtx + (size_t)(row - SEQ) * DM : srcLat + (size_t)row * DM;
        const float* mv = mod + (size_t)(L * 2 + (isc ? 1 : 0)) * NMOD;
        f32x4 v[8]; float ss = 0.f;
#pragma unroll
        for (int j = 0; j < 8; ++j) { v[j] = __builtin_nontemporal_load((const f32x4*)(src + NMC(j))); ss += (v[j].x * v[j].x + v[j].y * v[j].y) + (v[j].z * v[j].z + v[j].w * v[j].w); }
        if (npart > 0 && isc) {
            const float* pp = (const float*)(p.ws + WS_PART) + (size_t)(row - SEQ) * DM; ss = 0.f;
#pragma unroll
            for (int j = 0; j < 8; ++j) { f32x4 a = {0.f, 0.f, 0.f, 0.f};
                for (int k = 0; k < npart; ++k) a += *(const f32x4*)(pp + (size_t)k * 256 * DM + NMC(j));
                v[j] += *(const f32x4*)(pgate + NMC(j)) * a; ss += (v[j].x * v[j].x + v[j].y * v[j].y) + (v[j].z * v[j].z + v[j].w * v[j].w); }
            if (write_xr) { float* xr = (float*)(p.ws + WS_XR) + (size_t)row * DM;
#pragma unroll
                for (int j = 0; j < 8; ++j) *(f32x4*)(xr + NMC(j)) = v[j]; } }
        const float rstd = rsqrtf(wave_sum(ss) * (1.0f / DM) + 1e-6f);
#pragma unroll
        for (int jp = 0; jp < 4; ++jp) { const int col = NMC(2 * jp); f32x4 y[2];
#pragma unroll
            for (int q = 0; q < 2; ++q) { const int cq = col + 4 * q;
                const f32x4 w = *(const f32x4*)(normw + cq), sh = *(const f32x4*)(mv + o_shift * DM + cq), sc = *(const f32x4*)(mv + o_scale * DM + cq);
                y[q] = (v[2 * jp + q] * rstd) * w * (sc + 1.0f) + sh; }
            u32x4 o; o.x = pk2(y[0].x, y[0].y); o.y = pk2(y[0].z, y[0].w); o.z = pk2(y[1].x, y[1].y); o.w = pk2(y[1].z, y[1].w);
            *(u32x4*)(XN + (size_t)row * DM + col) = o; }
    }
}
#undef NMC

__device__ __forceinline__ void rope_cs(int pos, int i, float& cs, float& sn) {
    const float inv = exp2f(-(float)i * 0.83048202372184058696f);
    float r = ((float)pos * inv) * 0.15915494309189533577f; r = r - floorf(r);
    sn = __builtin_amdgcn_sinf(r); cs = __builtin_amdgcn_cosf(r);
}
__device__ __forceinline__ void phase_mixprep0(const Params& p, const Ctx& C) {
    const bf16_t* Z = (const bf16_t*)(p.ws + WS_Z0); bf16_t* KVN = (bf16_t*)(p.ws + WS_KVN); bf16_t* QN = (bf16_t*)(p.ws + WS_QN); bf16_t* KR = (bf16_t*)(p.ws + WS_KR); bf16_t* OA = (bf16_t*)(p.ws + WS_OA);
    const float* conv_a = p.in[8]; const float* q_norm = p.in[9]; const float* kv_norm = p.in[11];
    const int lane = C.lane;
    for (int row = C.gw; row < NTOK; row += C.NGW) {
        const bf16_t* z = Z + (size_t)row * ABN; const bool isc = row >= SEQ;
        const bool hasp = (row != 0) && (row != SEQ), hasn = (row != SEQ - 1) && (row != NTOK - 1);
        const u32x2 kvw = *(const u32x2*)(z + 4 * lane); const u32x4 qw = *(const u32x4*)(z + 320 + 8 * lane); const unsigned short krw = z[256 + lane];
        u32x4 ax[2], ab[2], acv[2], pax[2], pac[2], nax[2], nac[2];
#pragma unroll
        for (int j = 0; j < 2; ++j) { const int ch = 8 * lane + 512 * j;
            ax[j] = *(const u32x4*)(z + 832 + ch); ab[j] = *(const u32x4*)(z + 1856 + ch); acv[j] = *(const u32x4*)(z + 2880 + ch);
            pax[j] = (u32x4){0, 0, 0, 0}; pac[j] = pax[j]; nax[j] = pax[j]; nac[j] = pax[j];
            if (hasp) { pax[j] = *(const u32x4*)(z - ABN + 832 + ch); pac[j] = *(const u32x4*)(z - ABN + 2880 + ch); }
            if (hasn) { nax[j] = *(const u32x4*)(z + ABN + 832 + ch); nac[j] = *(const u32x4*)(z + ABN + 2880 + ch); } }
        {
            const u32x2 w = kvw; float a0 = blo(w.x), a1 = bhi(w.x), a2 = blo(w.y), a3 = bhi(w.y);
            const float rstd = rsqrtf(wave_sum(a0 * a0 + a1 * a1 + a2 * a2 + a3 * a3) * (1.0f / 256.f) + 1e-6f);
            const f32x4 g = *(const f32x4*)(kv_norm + 4 * lane);
            u32x2 o; o.x = pk2(a0 * rstd * g.x, a1 * rstd * g.y); o.y = pk2(a2 * rstd * g.z, a3 * rstd * g.w); *(u32x2*)(KVN + (size_t)row * 256 + 4 * lane) = o;
        }
        {
            const u32x4 w = qw; float a[8] = {blo(w.x), bhi(w.x), blo(w.y), bhi(w.y), blo(w.z), bhi(w.z), blo(w.w), bhi(w.w)};
            float ss = 0.f;
#pragma unroll
            for (int e = 0; e < 8; ++e) ss += a[e] * a[e];
            const float rstd = rsqrtf(wave_sum(ss) * (1.0f / 512.f) + 1e-6f);
            const f32x4 g0 = *(const f32x4*)(q_norm + 8 * lane), g1 = *(const f32x4*)(q_norm + 8 * lane + 4);
            u32x4 o; o.x = pk2(a[0] * rstd * g0.x, a[1] * rstd * g0.y); o.y = pk2(a[2] * rstd * g0.z, a[3] * rstd * g0.w); o.z = pk2(a[4] * rstd * g1.x, a[5] * rstd * g1.y); o.w = pk2(a[6] * rstd * g1.z, a[7] * rstd * g1.w);
            *(u32x4*)(QN + (size_t)row * 512 + 8 * lane) = o;
        }
        {
            const float x = bf2f(krw); const float xp = __shfl_xor(x, 16); const float rot = (lane & 16) ? xp : -xp;
            float cs = 1.f, sn = 0.f;
            if (!isc) rope_cs(lane < 32 ? (row >> 6) : (row & 63), lane & 15, cs, sn);
            KR[(size_t)row * 64 + lane] = (bf16_t)f2bf(x * cs + rot * sn);
        }
        {
#pragma unroll
            for (int j = 0; j < 2; ++j) { const int ch = 8 * lane + 512 * j;
                float o[8];
#pragma unroll
                for (int e = 0; e < 4; ++e) {
                    const float w0l = conv_a[ch + 2 * e], w1l = conv_a[1024 + ch + 2 * e], w2l = conv_a[2048 + ch + 2 * e];
                    const float w0h = conv_a[ch + 2 * e + 1], w1h = conv_a[1024 + ch + 2 * e + 1], w2h = conv_a[2048 + ch + 2 * e + 1];
                    o[2 * e] = blo(ab[j][e]) * (w0l * blo(pac[j][e]) * blo(pax[j][e]) + w1l * blo(acv[j][e]) * blo(ax[j][e]) + w2l * blo(nac[j][e]) * blo(nax[j][e]));
                    o[2 * e + 1] = bhi(ab[j][e]) * (w0h * bhi(pac[j][e]) * bhi(pax[j][e]) + w1h * bhi(acv[j][e]) * bhi(ax[j][e]) + w2h * bhi(nac[j][e]) * bhi(nax[j][e]));
                }
                u32x4 w; w.x = pk2(o[0], o[1]); w.y = pk2(o[2], o[3]); w.z = pk2(o[4], o[5]); w.w = pk2(o[6], o[7]);
                *(u32x4*)(OA + (size_t)row * DM + ch) = w; }
        }
    }
}

namespace attn {
constexpr int NW = 8, QBLK = 32, KVBLK = 64;
constexpr float SCALE = 0.07216878364870322f;
constexpr float THR = 8.f;
constexpr int SHM_V = KVBLK * 128 * 2, SHM_K = KVBLK * 128 * 2, SHM_KR = KVBLK * 64 * 2;
constexpr int OFF_V = 0, OFF_K = 2 * SHM_V, OFF_WS = OFF_K + 2 * SHM_K, OFF_KR = OFF_WS + NW * 64 * 4, OFF_QR = OFF_KR + 2 * SHM_KR, LDS_BYTES = OFF_QR + 256 * 128;
#define KSWZ(row, colB) ((row) * 256 + ((colB) ^ (((row) & 7) << 4)))
#define KSWZ2(row, colB) ((row) * 128 + ((colB) ^ (((row) & 7) << 4)))
#define SBAR() __builtin_amdgcn_sched_barrier(0)
__device__ __forceinline__ int crow(int r, int hi) { return (r & 3) + 8 * (r >> 2) + 4 * hi; }
__device__ __forceinline__ void partialSM(f32x16& p0, f32x16& p1, float& m_reg, float& mn, float& alpha) {
    constexpr float Cc = SCALE * 1.4426950408889634f;
    float pmax = p0[0];
#pragma unroll
    for (int r = 1; r < 16; ++r) pmax = fmaxf(pmax, p0[r]);
#pragma unroll
    for (int r = 0; r < 16; ++r) pmax = fmaxf(pmax, p1[r]);
    { auto rr = __builtin_amdgcn_permlane32_swap(__float_as_uint(pmax), __float_as_uint(pmax), false, false);
      pmax = fmaxf(__uint_as_float(rr[0]), __uint_as_float(rr[1])); }
    if (__builtin_expect(__all(pmax - m_reg <= THR / SCALE), 1)) { mn = m_reg; alpha = 1.f; }
    else { mn = fmaxf(m_reg, pmax); alpha = __builtin_amdgcn_exp2f((m_reg - mn) * Cc); m_reg = mn; }
    const float mnC = -mn * Cc;
#pragma unroll
    for (int r = 0; r < 16; ++r) p0[r] = fmaf(p0[r], Cc, mnC);
#pragma unroll
    for (int r = 0; r < 16; ++r) p1[r] = fmaf(p1[r], Cc, mnC);
#pragma unroll
    for (int r = 0; r < 16; ++r) p0[r] = __builtin_amdgcn_exp2f(p0[r]);
}
__device__ __forceinline__ void finishSM(f32x16& p0, f32x16& p1, float alpha, float& l_reg, bf16x8& pa0, bf16x8& pa1, bf16x8& pa2, bf16x8& pa3) {
#pragma unroll
    for (int r = 0; r < 16; ++r) p1[r] = __builtin_amdgcn_exp2f(p1[r]);
    float ps = 0;
#pragma unroll
    for (int r = 0; r < 16; ++r) ps += p0[r];
#pragma unroll
    for (int r = 0; r < 16; ++r) ps += p1[r];
    { auto rr = __builtin_amdgcn_permlane32_swap(__float_as_uint(ps), __float_as_uint(ps), false, false);
      ps = __uint_as_float(rr[0]) + __uint_as_float(rr[1]); }
    l_reg = l_reg * alpha + ps;
#define PK4(P, BASE, OUT) do { unsigned a0 = cvt_pk_bf16(P[BASE + 0], P[BASE + 1]), a1 = cvt_pk_bf16(P[BASE + 2], P[BASE + 3]);   \
    unsigned b0 = cvt_pk_bf16(P[BASE + 4], P[BASE + 5]), b1 = cvt_pk_bf16(P[BASE + 6], P[BASE + 7]);                              \
    auto r0 = __builtin_amdgcn_permlane32_swap(a0, b0, false, false); auto r1 = __builtin_amdgcn_permlane32_swap(a1, b1, false, false); \
    u32x4 w = {r0[0], r1[0], r0[1], r1[1]}; OUT = *reinterpret_cast<bf16x8*>(&w); } while (0)
    PK4(p0, 0, pa0); PK4(p0, 8, pa1); PK4(p1, 0, pa2); PK4(p1, 8, pa3);
#undef PK4
}
__device__ __forceinline__ void qkt(f32x16& p0, f32x16& p1, const char* Ks, const char* Krs, const char* Qrs, const bf16x8* qr, int r32, int hi, int qrow) {
    p0 = f32x16{}; p1 = f32x16{};
    asm volatile("" : "+v"(r32), "+v"(qrow));
#pragma unroll
    for (int d0 = 0; d0 < 8; ++d0) { const int cb = (d0 * 16 + hi * 8) * 2;
        const bf16x8 b0 = *reinterpret_cast<const bf16x8*>(Ks + KSWZ(r32, cb));
        const bf16x8 b1 = *reinterpret_cast<const bf16x8*>(Ks + KSWZ(32 + r32, cb));
        p0 = __builtin_amdgcn_mfma_f32_32x32x16_bf16(b0, qr[d0], p0, 0, 0, 0);
        p1 = __builtin_amdgcn_mfma_f32_32x32x16_bf16(b1, qr[d0], p1, 0, 0, 0); }
#pragma unroll
    for (int d0 = 0; d0 < 4; ++d0) { const int cb = (d0 * 16 + hi * 8) * 2;
        const bf16x8 b0 = *reinterpret_cast<const bf16x8*>(Krs + KSWZ2(r32, cb));
        const bf16x8 b1 = *reinterpret_cast<const bf16x8*>(Krs + KSWZ2(32 + r32, cb));
        const bf16x8 qf = *reinterpret_cast<const bf16x8*>(Qrs + KSWZ2(qrow, cb));
        p0 = __builtin_amdgcn_mfma_f32_32x32x16_bf16(b0, qf, p0, 0, 0, 0);
        p1 = __builtin_amdgcn_mfma_f32_32x32x16_bf16(b1, qf, p1, 0, 0, 0); }
}
__device__ __forceinline__ int v_st(int k, int c) { const int kk = (k & ~0xC) | ((k & 4) << 1) | ((k & 8) >> 1); return ((kk >> 3) * 4 + (c >> 5)) * 512 + ((kk & 7) * 32 + (c & 31)) * 2; }
__device__ __forceinline__ int v_rd_base(int lane) { return ((lane & 3) << 3) | (((lane >> 2) & 3) << 6) | (((lane >> 4) & 1) << 5) | (((lane >> 5) & 1) << 8); }
constexpr int v_rd_off(int d0, int ks, int half) { return d0 * 512 + ks * 4096 + half * 2048; }
template <int OFF> __device__ __forceinline__ s16x4 tr_read(int vb) {
    s16x4 r; asm volatile("ds_read_b64_tr_b16 %0, %1 offset:%2" : "=&v"(r) : "v"(vb), "i"(OFF) : "memory"); return r;
}
template <int D0> __device__ __forceinline__ void pv_one(f32x16& od, int vb, bf16x8 pa0, bf16x8 pa1, bf16x8 pa2, bf16x8 pa3) {
    const s16x4 l0 = tr_read<v_rd_off(D0, 0, 0)>(vb), h0 = tr_read<v_rd_off(D0, 0, 1)>(vb), l1 = tr_read<v_rd_off(D0, 1, 0)>(vb), h1 = tr_read<v_rd_off(D0, 1, 1)>(vb);
    const s16x4 l2 = tr_read<v_rd_off(D0, 2, 0)>(vb), h2 = tr_read<v_rd_off(D0, 2, 1)>(vb), l3 = tr_read<v_rd_off(D0, 3, 0)>(vb), h3 = tr_read<v_rd_off(D0, 3, 1)>(vb);
    asm volatile("s_waitcnt lgkmcnt(0)" ::: "memory"); SBAR();
#define PK(L, H) (bf16x8){L[0], L[1], L[2], L[3], H[0], H[1], H[2], H[3]}
    od = __builtin_amdgcn_mfma_f32_32x32x16_bf16(pa0, PK(l0, h0), od, 0, 0, 0);
    od = __builtin_amdgcn_mfma_f32_32x32x16_bf16(pa1, PK(l1, h1), od, 0, 0, 0);
    od = __builtin_amdgcn_mfma_f32_32x32x16_bf16(pa2, PK(l2, h2), od, 0, 0, 0);
    od = __builtin_amdgcn_mfma_f32_32x32x16_bf16(pa3, PK(l3, h3), od, 0, 0, 0);
#undef PK
}
__device__ __forceinline__ void pv_d0(f32x16* o, int vb, bf16x8 pa0, bf16x8 pa1, bf16x8 pa2, bf16x8 pa3) {
    pv_one<0>(o[0], vb, pa0, pa1, pa2, pa3); pv_one<1>(o[1], vb, pa0, pa1, pa2, pa3); pv_one<2>(o[2], vb, pa0, pa1, pa2, pa3); pv_one<3>(o[3], vb, pa0, pa1, pa2, pa3);
}

__device__ __forceinline__ void unit(const bf16_t* __restrict__ Qh, const bf16_t* __restrict__ Kh, const bf16_t* __restrict__ Vh, const bf16_t* __restrict__ KRh,
                                     bf16_t* __restrict__ Ob, int seq, int grow0, char* lds) {
    constexpr int LDQ = 1536, LDK = 2048, LDO = 2048;
    const int tid = threadIdx.x, wid = tid >> 6, lane = tid & 63, r32 = lane & 31, hi = lane >> 5;
    char* V_lds = lds + OFF_V; char* K_lds = lds + OFF_K; char* Kr_lds = lds + OFF_KR; char* Qr_lds = lds + OFF_QR;
    float* wsf = (float*)(lds + OFF_WS) + wid * 64; float* li_l = wsf; float* al_l = wsf + 32;
    float m_reg = -1e30f, l_reg = 0; f32x16 o[4] = {}; bf16x8 qr[8];
    const bf16_t* Qw = Qh + (long)(wid * QBLK + r32) * LDQ + hi * 8;
#pragma unroll
    for (int d0 = 0; d0 < 8; ++d0) qr[d0] = *reinterpret_cast<const bf16x8*>(Qw + d0 * 16);
    {
        const int row = tid >> 1, half = tid & 1; const bf16_t* qp = Qh + (long)row * LDQ + 128 + half * 32;
        u32x4 w[4];
#pragma unroll
        for (int i = 0; i < 4; ++i) w[i] = *(const u32x4*)(qp + 8 * i);
        float x[32];
#pragma unroll
        for (int i = 0; i < 4; ++i)
#pragma unroll
            for (int e = 0; e < 4; ++e) { x[8 * i + 2 * e] = blo(w[i][e]); x[8 * i + 2 * e + 1] = bhi(w[i][e]); }
        float y[32];
        const int pos = grow0 < 0 ? 0 : (half == 0 ? ((grow0 + row) >> 6) : ((grow0 + row) & 63));
#pragma unroll
        for (int i = 0; i < 16; ++i) { float cs = 1.f, sn = 0.f; if (grow0 >= 0) rope_cs(pos, i, cs, sn);
            y[i] = x[i] * cs - x[16 + i] * sn; y[16 + i] = x[16 + i] * cs + x[i] * sn; }
#pragma unroll
        for (int i = 0; i < 4; ++i) { u32x4 ov; ov.x = pk2(y[8 * i], y[8 * i + 1]); ov.y = pk2(y[8 * i + 2], y[8 * i + 3]); ov.z = pk2(y[8 * i + 4], y[8 * i + 5]); ov.w = pk2(y[8 * i + 6], y[8 * i + 7]);
            *(u32x4*)(Qr_lds + KSWZ2(row, (half * 32 + 8 * i) * 2)) = ov; }
    }
    const int qrow = wid * QBLK + r32;
    const int sr = tid >> 4, sc = (tid & 15) * 8, vst0 = v_st(sr, sc), vst1 = v_st(32 + sr, sc);
    const int krr = tid >> 3, krc = (tid & 7) * 8;
    const int vb0 = (int)(uintptr_t)V_lds + v_rd_base(lane);
    struct { bf16x8 vs0, vs1, ks0, ks1, kr; } sr_[1];
#define LD8(p) (*reinterpret_cast<const bf16x8*>(p))
    const unsigned off0 = (unsigned)(sr * LDK + sc) * 2u, off1 = off0 + 32u * LDK * 2u, offr = (unsigned)(krr * 64 + krc) * 2u;
#define SLOAD(i, k0) do { const char* vb_ = (const char*)Vh + (size_t)(k0) * (LDK * 2); const char* kb_ = (const char*)Kh + (size_t)(k0) * (LDK * 2); const char* rb_ = (const char*)KRh + (size_t)(k0) * 128; \
    sr_[i].vs0 = LD8(vb_ + off0); sr_[i].vs1 = LD8(vb_ + off1); sr_[i].ks0 = LD8(kb_ + off0); sr_[i].ks1 = LD8(kb_ + off1); sr_[i].kr = LD8(rb_ + offr); } while (0)
#define SWRITE(b, i) do { *(bf16x8*)(V_lds + (b) * SHM_V + vst0) = sr_[i].vs0;          \
    *(bf16x8*)(V_lds + (b) * SHM_V + vst1) = sr_[i].vs1; const int kc = sc * 2;               \
    *(bf16x8*)(K_lds + (b) * SHM_K + KSWZ(sr, kc)) = sr_[i].ks0;                       \
    *(bf16x8*)(K_lds + (b) * SHM_K + KSWZ(32 + sr, kc)) = sr_[i].ks1;                  \
    *(bf16x8*)(Kr_lds + (b) * SHM_KR + KSWZ2(krr, krc * 2)) = sr_[i].kr; } while (0)
#define SWAIT() asm volatile("s_waitcnt vmcnt(0)" ::: "memory")
#define RESC(a) do { if (__any((a) < 1.f)) { if (hi == 0) al_l[r32] = (a); asm volatile("s_waitcnt lgkmcnt(0)" ::: "memory"); \
    _Pragma("unroll") for (int d = 0; d < 4; ++d) _Pragma("unroll") for (int r = 0; r < 16; ++r) o[d][r] *= al_l[crow(r, hi)]; } } while (0)
    f32x16 pA0, pA1, pB0, pB1; float mnA, mnB, alA, alB; bf16x8 pa0, pa1, pa2, pa3; const int NT = seq / KVBLK;
    constexpr int SE = 0, SO = 0;
    SLOAD(SE, 0); asm volatile("s_waitcnt vmcnt(0)" ::: "memory"); SWRITE(0, SE); __syncthreads();
    qkt(pA0, pA1, K_lds, Kr_lds, Qr_lds, qr, r32, hi, qrow); partialSM(pA0, pA1, m_reg, mnA, alA);
    SLOAD(SO, KVBLK);
    SWAIT(); SWRITE(1, SO); __syncthreads();
    for (int j = 1; j + 1 < NT; j += 2) {
        SBAR(); qkt(pB0, pB1, K_lds + SHM_K, Kr_lds + SHM_KR, Qr_lds, qr, r32, hi, qrow);
        finishSM(pA0, pA1, alA, l_reg, pa0, pa1, pa2, pa3); SBAR();
        SLOAD(SO, (j + 1) * KVBLK); SBAR();
        pv_d0(o, vb0, pa0, pa1, pa2, pa3); partialSM(pB0, pB1, m_reg, mnB, alB);
        __syncthreads(); SWAIT(); SWRITE(0, SE);
        RESC(alB); __syncthreads();
        SBAR(); qkt(pA0, pA1, K_lds, Kr_lds, Qr_lds, qr, r32, hi, qrow);
        finishSM(pB0, pB1, alB, l_reg, pa0, pa1, pa2, pa3); SBAR();
        SLOAD(SE, (j + 2) * KVBLK); SBAR();
        pv_d0(o, vb0 + SHM_V, pa0, pa1, pa2, pa3); partialSM(pA0, pA1, m_reg, mnA, alA);
        __syncthreads(); SWAIT(); SWRITE(1, SO);
        RESC(alA); __syncthreads();
    }
    SBAR(); qkt(pB0, pB1, K_lds + SHM_K, Kr_lds + SHM_KR, Qr_lds, qr, r32, hi, qrow);
    finishSM(pA0, pA1, alA, l_reg, pa0, pa1, pa2, pa3); SBAR();
    pv_d0(o, vb0, pa0, pa1, pa2, pa3); partialSM(pB0, pB1, m_reg, mnB, alB);
    __syncthreads(); RESC(alB);
    finishSM(pB0, pB1, alB, l_reg, pa0, pa1, pa2, pa3); SBAR();
    pv_d0(o, vb0 + SHM_V, pa0, pa1, pa2, pa3);
    if (hi == 0) li_l[r32] = l_reg; asm volatile("s_waitcnt lgkmcnt(0)" ::: "memory");
    float rli[16];
#pragma unroll
    for (int r = 0; r < 16; ++r) rli[r] = __builtin_amdgcn_rcpf(li_l[crow(r, hi)]);
    bf16_t* Ow = Ob + (long)(wid * QBLK) * LDO;
#pragma unroll
    for (int r = 0; r < 16; ++r) { const int orow = crow(r, hi);
#pragma unroll
        for (int d0 = 0; d0 < 4; ++d0) Ow[(long)orow * LDO + d0 * 32 + r32] = (bf16_t)f2bf(o[d0][r] * rli[r]); }
#undef SLOAD
#undef SWRITE
#undef SWAIT
#undef RESC
#undef LD8
}
}

__device__ __forceinline__ void phase_attention(const Params& p, const Ctx& C, char* lds_generic) {
    const bf16_t* Q = (const bf16_t*)(p.ws + WS_Q); const bf16_t* KV = (const bf16_t*)(p.ws + WS_KV); const bf16_t* KR = (const bf16_t*)(p.ws + WS_KR); bf16_t* OA = (bf16_t*)(p.ws + WS_OA);
    for (int u = C.bid; u < 264; u += C.G) {
        int h, row0, key0, nkeys, grow0;
        if (u < 256) { h = u & 7; row0 = (u >> 3) * 256; key0 = 0; nkeys = NTOK; grow0 = row0; }
        else { h = u - 256; row0 = SEQ; key0 = SEQ; nkeys = CTX; grow0 = -1; }
        __syncthreads();
        attn::unit(Q + (size_t)row0 * 1536 + h * 192, KV + (size_t)key0 * 2048 + h * 256, KV + (size_t)key0 * 2048 + h * 256 + 128, KR + (size_t)key0 * 64,
                   OA + (size_t)row0 * DM + 1024 + h * 128, nkeys, grow0, lds_generic);
    }
    __syncthreads();
}

__device__ __forceinline__ void unpack8(const u32x4 w, float (&f)[8]) {
#pragma unroll
    for (int e = 0; e < 4; ++e) { f[2 * e] = blo(w[e]); f[2 * e + 1] = bhi(w[e]); }
}
__device__ __forceinline__ void phase_convact(const Params& p, const Ctx& C, const float* cw, const float* cb, int nrows) {
    const bf16_t* U = (const bf16_t*)(p.ws + WS_U); bf16_t* H = (bf16_t*)(p.ws + WS_H);
    const int nstrip = nrows / 16, nitems = nstrip * 704;
    for (int it = C.bid * 512 + C.tid; it < nitems; it += C.G * 512) {
        const int strip = it / 704, cgp = it % 704, r0 = strip * 16, cg0 = 8 * cgp, cv0 = DFF + 8 * cgp;
        const int lo = r0 >= SEQ ? SEQ : 0, hiE = r0 >= SEQ ? NTOK : SEQ;
        float wg[3][8], wv[3][8], bg[8], bv[8];
#pragma unroll
        for (int k = 0; k < 3; ++k)
#pragma unroll
            for (int e = 0; e < 8; ++e) { wg[k][e] = cw[k * DFF2 + cg0 + e]; wv[k][e] = cw[k * DFF2 + cv0 + e]; }
#pragma unroll
        for (int e = 0; e < 8; ++e) { bg[e] = cb[cg0 + e]; bv[e] = cb[cv0 + e]; }
        const u32x4 zero = {0, 0, 0, 0};
        u32x4 pgw = r0 > lo ? __builtin_nontemporal_load((const u32x4*)(U + (size_t)(r0 - 1) * DFF2 + cg0)) : zero, pvw = r0 > lo ? __builtin_nontemporal_load((const u32x4*)(U + (size_t)(r0 - 1) * DFF2 + cv0)) : zero;
        u32x4 cgw = __builtin_nontemporal_load((const u32x4*)(U + (size_t)r0 * DFF2 + cg0)), cvw = __builtin_nontemporal_load((const u32x4*)(U + (size_t)r0 * DFF2 + cv0));
        for (int rb = r0; rb < r0 + 16; rb += 4) {
            u32x4 ngw[4], nvw[4];
#pragma unroll
            for (int q = 0; q < 4; ++q) { const bool hn = (rb + q + 1) < hiE;
                ngw[q] = hn ? __builtin_nontemporal_load((const u32x4*)(U + (size_t)(rb + q + 1) * DFF2 + cg0)) : zero; nvw[q] = hn ? __builtin_nontemporal_load((const u32x4*)(U + (size_t)(rb + q + 1) * DFF2 + cv0)) : zero; }
#pragma unroll
            for (int q = 0; q < 4; ++q) {
                float pg[8], pv[8], cgv[8], cvv[8], ng[8], nv[8];
                unpack8(pgw, pg); unpack8(pvw, pv); unpack8(cgw, cgv); unpack8(cvw, cvv); unpack8(ngw[q], ng); unpack8(nvw[q], nv);
                float o[8];
#pragma unroll
                for (int e = 0; e < 8; ++e) { const float gsum = wg[0][e] * pg[e] + wg[1][e] * cgv[e] + wg[2][e] * ng[e] + bg[e];
                    const float vsum = wv[0][e] * pv[e] + wv[1][e] * cvv[e] + wv[2][e] * nv[e] + bv[e];
                    o[e] = silu_f(gsum) * vsum; }
                u32x4 w; w.x = pk2(o[0], o[1]); w.y = pk2(o[2], o[3]); w.z = pk2(o[4], o[5]); w.w = pk2(o[6], o[7]);
                *(u32x4*)(H + (size_t)(rb + q) * DFF + cg0) = w;
                pgw = cgw; pvw = cvw; cgw = ngw[q]; cvw = nvw[q];
            }
        }
    }
}

__device__ __forceinline__ size_t aq_off(int h, int c) { return ((size_t)(h * 32 + c) * 256) * 768; }
__device__ __forceinline__ size_t ke_off(int d, int h, int c) { return ((size_t)((d * 4 + h) * 32 + c) * 256) * 256; }
__device__ __forceinline__ size_t kdt_off(int d, int h, int c) { return ((size_t)((d * 4 + h) * NCH + c) * 256) * 256; }
__device__ __forceinline__ size_t bt4_off(int h, int c) { return ((size_t)(h * NCH + c) * 512) * 768; }
__device__ __forceinline__ size_t kvt_off(int d, int h, int c) { return ((size_t)((d * 4 + h) * NCH + c) * 512) * 256; }

__device__ __forceinline__ float logsig16(float x) { return -(fmaxf(-x, 0.f) + __logf(1.0f + __expf(-fabsf(x)))) * (1.0f / 16.0f); }

__device__ __forceinline__ void phase_gla_prep(const Params& p, const Ctx& C) {
    const bf16_t* Z = (const bf16_t*)(p.ws + WS_Z1);
    bf16_t* AQ = (bf16_t*)(p.ws + WS_AQ); bf16_t* KE = (bf16_t*)(p.ws + WS_KE); bf16_t* KDT = (bf16_t*)(p.ws + WS_KDT); bf16_t* BT4 = (bf16_t*)(p.ws + WS_BT4);
    float* DEC = (float*)(p.ws + WS_DEC);
    const float* gfw = p.in[23]; const float* gfb = p.in[24]; const float* gbw = p.in[25]; const float* gbb = p.in[26];
    LAS float* red = (LAS float*)C.lds;
    const int col = C.tid & 31, sub = C.tid >> 5;
    for (int it0 = C.bid; it0 < NCH * 32 * G1REP; it0 += C.G) { const int it = it0 % (NCH * 32);
        const int c = it >> 5, h = (it >> 3) & 3, cb = it & 7; const int j = cb * 32 + col, gc = h * 256 + j;
        float wf[16], wb[16];
#pragma unroll
        for (int r = 0; r < 16; ++r) { wf[r] = gfw[r * 1024 + gc]; wb[r] = gbw[r * 1024 + gc]; }
        const float bf_ = gfb[gc], bb_ = gbb[gc];
        const int tok0 = c * 256 + sub * 16;
        float gf[16], gb[16]; float sf = 0.f, sb = 0.f;
#pragma unroll
        for (int t = 0; t < 16; ++t) {
            const bf16_t* lr = Z + (size_t)(tok0 + t) * GLN + 6144;
            const u32x4 a0 = *(const u32x4*)(lr), a1 = *(const u32x4*)(lr + 8), b0 = *(const u32x4*)(lr + 16), b1 = *(const u32x4*)(lr + 24);
            float xf = bf_, xb = bb_;
#pragma unroll
            for (int e = 0; e < 4; ++e) {
                xf += wf[2 * e] * blo(a0[e]) + wf[2 * e + 1] * bhi(a0[e]) + wf[8 + 2 * e] * blo(a1[e]) + wf[8 + 2 * e + 1] * bhi(a1[e]);
                xb += wb[2 * e] * blo(b0[e]) + wb[2 * e + 1] * bhi(b0[e]) + wb[8 + 2 * e] * blo(b1[e]) + wb[8 + 2 * e + 1] * bhi(b1[e]); }
            gf[t] = logsig16(xf); gb[t] = logsig16(xb); sf += gf[t]; sb += gb[t];
        }
        __syncthreads();
        red[sub * 32 + col] = sf; red[512 + sub * 32 + col] = sb;
        __syncthreads();
        float offf = 0.f, totf = 0.f, offb = 0.f, totb = 0.f;
#pragma unroll
        for (int s2 = 0; s2 < 16; ++s2) { const float a = red[s2 * 32 + col], b = red[512 + s2 * 32 + col]; totf += a; totb += b; if (s2 < sub) offf += a; if (s2 > sub) offb += b; }
        if (sub == 0) { DEC[((0 * 4 + h) * NCH + c) * 256 + j] = __expf(totf); DEC[((1 * 4 + h) * NCH + c) * 256 + j] = __expf(totb); }
        float Bf = offf, pb = 0.f;
        unsigned kdf[8], kdb[8]; float kdf_lo = 0.f, kdb_lo = 0.f;
        const bool lat = c < 32;
        bf16_t* aq = AQ + (lat ? aq_off(h, c) : 0); bf16_t* kef = KE + (lat ? ke_off(0, h, c) : 0); bf16_t* keb = KE + (lat ? ke_off(1, h, c) : 0);
        {
            unsigned short q8[16], k8[16];
#pragma unroll
            for (int t = 0; t < 16; ++t) { const bf16_t* zr = Z + (size_t)(tok0 + t) * GLN; q8[t] = zr[3072 + gc]; k8[t] = zr[gc]; }
#pragma unroll
            for (int t = 0; t < 16; ++t) {
                Bf += gf[t]; const float Bb = offb + sb - pb; pb += gb[t];
                const int tl = sub * 16 + t;
                const float q = bf2f(q8[t]) * 0.0625f, k = bf2f(k8[t]);
                const float kd_f = k * __expf(totf - Bf), kd_b = k * __expf(totb - Bb);
                if (lat) {
                    aq[(size_t)tl * 768 + j] = (bf16_t)f2bf(q * __expf(Bf)); aq[(size_t)tl * 768 + 256 + j] = (bf16_t)f2bf(q * __expf(Bb));
                    kef[(size_t)tl * 256 + j] = (bf16_t)f2bf(k * __expf(-Bf)); keb[(size_t)tl * 256 + j] = (bf16_t)f2bf(k * __expf(-Bb));
                }
                if (t & 1) { kdf[t >> 1] = pk2(kdf_lo, kd_f); kdb[t >> 1] = pk2(kdb_lo, kd_b); } else { kdf_lo = kd_f; kdb_lo = kd_b; }
            }
        }
        bf16_t* kf = KDT + kdt_off(0, h, c) + (size_t)j * 256 + sub * 16; bf16_t* kb = KDT + kdt_off(1, h, c) + (size_t)j * 256 + sub * 16;
#pragma unroll
        for (int q4 = 0; q4 < 2; ++q4) { *(u32x4*)(kf + 8 * q4) = (u32x4){kdf[4 * q4], kdf[4 * q4 + 1], kdf[4 * q4 + 2], kdf[4 * q4 + 3]};
                                         *(u32x4*)(kb + 8 * q4) = (u32x4){kdb[4 * q4], kdb[4 * q4 + 1], kdb[4 * q4 + 2], kdb[4 * q4 + 3]}; }
    }
    __syncthreads();
    LAS bf16_t* tl = (LAS bf16_t*)(C.lds + 8192 + C.wave * 8448);
    for (int it0 = C.gw; it0 < NCH * 4 * 4 * 8 * G1REP; it0 += C.NGW) { const int it = it0 % (NCH * 4 * 4 * 8);
        const int dvb = it & 7, tb = (it >> 3) & 3, h = (it >> 5) & 3, c = it >> 7;
#pragma unroll
        for (int i = 0; i < 8; ++i) { const int r = i * 8 + (C.lane >> 3), ch = C.lane & 7;
            const u32x4 w = __builtin_nontemporal_load((const u32x4*)(Z + (size_t)(c * 256 + tb * 64 + r) * GLN + 1024 + h * 512 + dvb * 64 + ch * 8));
            LAS unsigned* d = (LAS unsigned*)(tl + r * 66 + ch * 8); d[0] = w.x; d[1] = w.y; d[2] = w.z; d[3] = w.w; }
        LDS_WAIT(); asm volatile("" ::: "memory");
#pragma unroll
        for (int i = 0; i < 8; ++i) { const int dv = i * 8 + (C.lane >> 3), tc = C.lane & 7;
            unsigned short e[8];
#pragma unroll
            for (int k = 0; k < 8; ++k) e[k] = tl[(tc * 8 + k) * 66 + dv];
            u32x4 w; w.x = e[0] | ((unsigned)e[1] << 16); w.y = e[2] | ((unsigned)e[3] << 16); w.z = e[4] | ((unsigned)e[5] << 16); w.w = e[6] | ((unsigned)e[7] << 16);
            *(u32x4*)(BT4 + bt4_off(h, c) + (size_t)(dvb * 64 + dv) * 768 + 512 + tb * 64 + tc * 8) = w; }
        LDS_WAIT(); asm volatile("" ::: "memory");
    }
}

struct G2aSched {
    int G, c; unsigned char* ws;
    __device__ bool next(int i, pg8::Unit& u) const {
        const int L = i * G + c; if (L >= 256) return false;
        u.id = L; const int d = L >> 7;
        u.A = (const char*)((bf16_t*)(ws + WS_AQ) + (size_t)(L & 127) * (256 * 768) + d * 256); u.B = (const char*)((bf16_t*)(ws + WS_KE) + (size_t)L * 65536); return true;
    }
    __device__ __forceinline__ void out(const pg8::Unit& u, pg8::OutInfo& o) const { o.O = (bf16_t*)(ws + WS_AT) + (size_t)u.id * 65536; o.ldc = 256; o.mask = 0; o.r0 = 0; o.c0 = 0; }
};
struct G2bSched {
    int G, c; unsigned char* ws;
    __device__ __forceinline__ static int chunk(int cp, int d) { return cp == 0 ? 32 : (d == 0 ? cp - 1 : cp); }
    __device__ bool next(int i, pg8::Unit& u) const {
        const int L = i * G + c; if (L >= 512) return false;
        u.id = L; const int mh = L & 1, hd = (L >> 1) & 7, h = hd & 3, cc = chunk(L >> 4, hd >> 2);
        u.A = (const char*)((bf16_t*)(ws + WS_BT4) + (size_t)((h * NCH + cc) * 512 + mh * 256) * 768 + 512); u.B = (const char*)((bf16_t*)(ws + WS_KDT) + (size_t)(hd * NCH + cc) * 65536); return true;
    }
    __device__ __forceinline__ void out(const pg8::Unit& u, pg8::OutInfo& o) const { const int L = u.id, mh = L & 1, hd = (L >> 1) & 7, cc = chunk(L >> 4, hd >> 2);
        o.O = (bf16_t*)(ws + WS_KVT) + (size_t)((hd * NCH + cc) * 512 + mh * 256) * 256; o.ldc = 256; o.mask = 0; o.r0 = 0; o.c0 = 0; }
};
struct G4Sched {
    int G, c; unsigned char* ws;
    __device__ bool next(int i, pg8::Unit& u) const {
        const int L0 = i * G + c; if (L0 >= 256) return false;
        const int L = (((L0 >> 4) << 3 | (L0 & 7)) << 1) | ((L0 >> 3) & 1);
        const int nh = L & 1, cc = (L >> 1) & 31, h = L >> 6; u.id = L;
        u.A = (const char*)((bf16_t*)(ws + WS_AQ) + aq_off(h, cc)); u.B = (const char*)((bf16_t*)(ws + WS_BT4) + bt4_off(h, cc) + (size_t)(nh * 256) * 768); return true;
    }
    __device__ __forceinline__ void out(const pg8::Unit& u, pg8::OutInfo& o) const {
        const int L = u.id, nh = L & 1, cc = (L >> 1) & 31, h = L >> 6;
        o.O = (bf16_t*)(ws + WS_O) + (size_t)(cc * 256) * DM + h * 512 + nh * 256; o.ldc = DM; o.mask = 0; o.r0 = L; o.c0 = 0;
    }
};

__device__ __forceinline__ void phase_gla_scan(const Params& p, const Ctx& C) {
    const bf16_t* KVT = (const bf16_t*)(p.ws + WS_KVT); const float* DEC = (const float*)(p.ws + WS_DEC); bf16_t* BT4 = (bf16_t*)(p.ws + WS_BT4);
    for (int it = C.bid * 512 + C.tid; it < 2 * 4 * 512 * 32; it += C.G * 512) {
        const int dk8 = it & 31, dv = (it >> 5) & 511, h = (it >> 14) & 3, d = it >> 16; const int dk = dk8 * 8;
        float S[8];
#pragma unroll
        for (int e = 0; e < 8; ++e) S[e] = 0.f;
        for (int s0 = 0; s0 < NCH; s0 += 3) {
            u32x4 kvw[3]; f32x4 da[3], db[3]; int cc[3];
#pragma unroll
            for (int q = 0; q < 3; ++q) { const int s = s0 + q; const int c = (s == 0) ? 32 : (d == 0 ? s - 1 : 32 - s); cc[q] = c;
                if (s < NCH - 1) { kvw[q] = __builtin_nontemporal_load((const u32x4*)(KVT + kvt_off(d, h, c) + (size_t)dv * 256 + dk));
                    const float* dc = DEC + ((d * 4 + h) * NCH + c) * 256 + dk; da[q] = *(const f32x4*)dc; db[q] = *(const f32x4*)(dc + 4); } }
#pragma unroll
            for (int q = 0; q < 3; ++q) { const int s = s0 + q; const int c = cc[q];
                if (s > 0) { u32x4 w; w.x = pk2(S[0], S[1]); w.y = pk2(S[2], S[3]); w.z = pk2(S[4], S[5]); w.w = pk2(S[6], S[7]);
                    *(u32x4*)(BT4 + bt4_off(h, c) + (size_t)dv * 768 + d * 256 + dk) = w; }
                if (s < NCH - 1) { float f[8]; unpack8(kvw[q], f); const f32x4 d0 = da[q], d1 = db[q];
                    S[0] = d0.x * S[0] + f[0]; S[1] = d0.y * S[1] + f[1]; S[2] = d0.z * S[2] + f[2]; S[3] = d0.w * S[3] + f[3];
                    S[4] = d1.x * S[4] + f[4]; S[5] = d1.y * S[5] + f[5]; S[6] = d1.z * S[6] + f[6]; S[7] = d1.w * S[7] + f[7]; } }
        }
    }
    bf16_t* AQ = (bf16_t*)(p.ws + WS_AQ); const bf16_t* AT = (const bf16_t*)(p.ws + WS_AT);
    for (int it0 = C.bid * 512 + C.tid; it0 < 128 * 256 * 32; it0 += 4 * C.G * 512) {
        u32x4 xw[4], yw[4];
#pragma unroll
        for (int q = 0; q < 4; ++q) { const int it = it0 + q * C.G * 512; if (it < 128 * 256 * 32) { const int j8 = it & 31, i = (it >> 5) & 255, hc = it >> 13;
            const bf16_t* bfw = AT + (size_t)hc * 65536 + (size_t)i * 256 + j8 * 8; xw[q] = __builtin_nontemporal_load((const u32x4*)bfw); yw[q] = __builtin_nontemporal_load((const u32x4*)(bfw + (size_t)128 * 65536)); } }
#pragma unroll
        for (int q = 0; q < 4; ++q) { const int it = it0 + q * C.G * 512; if (it < 128 * 256 * 32) { const int j8 = it & 31, i = (it >> 5) & 255, hc = it >> 13;
            float fx[8], fy[8]; unpack8(xw[q], fx); unpack8(yw[q], fy);
#pragma unroll
            for (int e = 0; e < 8; ++e) { const int j = j8 * 8 + e; fx[e] = (j <= i) ? fx[e] : 0.f; fy[e] = (j >= i) ? fy[e] : 0.f; }
            u32x4 w; w.x = pk2(fx[0] + fy[0], fx[1] + fy[1]); w.y = pk2(fx[2] + fy[2], fx[3] + fy[3]); w.z = pk2(fx[4] + fy[4], fx[5] + fy[5]); w.w = pk2(fx[6] + fy[6], fx[7] + fy[7]);
            *(u32x4*)(AQ + (size_t)hc * 256 * 768 + (size_t)i * 768 + 512 + j8 * 8) = w; } }
    }
}

__device__ __forceinline__ void phase_gla_out(const Params& p, const Ctx& C) {
    const bf16_t* O = (const bf16_t*)(p.ws + WS_O); const bf16_t* Z = (const bf16_t*)(p.ws + WS_Z1); bf16_t* OG = (bf16_t*)(p.ws + WS_OG); const float* onorm = p.in[27];
    const f32x4 g0 = *(const f32x4*)(onorm + 8 * C.lane), g1 = *(const f32x4*)(onorm + 8 * C.lane + 4);
    const float gw8[8] = {g0.x, g0.y, g0.z, g0.w, g1.x, g1.y, g1.z, g1.w};
    for (int row = C.gw; row < SEQ; row += C.NGW) {
#pragma unroll
        for (int h = 0; h < 4; ++h) {
            const u32x4 ow = *(const u32x4*)(O + (size_t)row * DM + h * 512 + 8 * C.lane), gwv = *(const u32x4*)(Z + (size_t)row * GLN + 4096 + h * 512 + 8 * C.lane);
            float o[8], g[8]; unpack8(ow, o); unpack8(gwv, g);
            float ss = 0.f;
#pragma unroll
            for (int e = 0; e < 8; ++e) ss += o[e] * o[e];
            const float rstd = rsqrtf(wave_sum(ss) * (1.0f / 512.f) + 1e-6f);
            float y[8];
#pragma unroll
            for (int e = 0; e < 8; ++e) y[e] = o[e] * rstd * gw8[e] * silu_f(g[e]);
            u32x4 w; w.x = pk2(y[0], y[1]); w.y = pk2(y[2], y[3]); w.z = pk2(y[4], y[5]); w.w = pk2(y[6], y[7]);
            *(u32x4*)(OG + (size_t)row * DM + h * 512 + 8 * C.lane) = w;
        }
    }
}

__device__ __forceinline__ void phase_final(const Params& p, const Ctx& C) {
    const float* XR = (const float*)(p.ws + WS_XR); const float* fw = p.in[34];
    for (int row = C.gw; row < SEQ; row += C.NGW) {
        const float* src = XR + (size_t)row * DM; f32x4 v[8]; float ss = 0.f;
#pragma unroll
        for (int j = 0; j < 8; ++j) { v[j] = *(const f32x4*)(src + 4 * C.lane + 256 * j); ss += (v[j].x * v[j].x + v[j].y * v[j].y) + (v[j].z * v[j].z + v[j].w * v[j].w); }
        const float rstd = rsqrtf(wave_sum(ss) * (1.0f / DM) + 1e-6f);
#pragma unroll
        for (int j = 0; j < 8; ++j) { const int col = 4 * C.lane + 256 * j; const f32x4 w = *(const f32x4*)(fw + col);
            *(f32x4*)(p.out + (size_t)row * DM + col) = (v[j] * rstd) * w; }
    }
}

#define XB_TMO      128
#define XB_XCNT(j)  (256  + 64 * (j))
#define XB_XSUB(j)  (1280 + 64 * (j))
#define XB_XGEN(j)  (2304 + 64 * (j))
#define XB_TOP      3328
#define XB_TOPGEN   3392
#define XCD_BAR_WORDS 3456
#define XB_SPIN_CAP (1u << 22)
__device__ __forceinline__ unsigned xb_ld(unsigned* p)              { return __hip_atomic_load(p, __ATOMIC_RELAXED, __HIP_MEMORY_SCOPE_AGENT); }
__device__ __forceinline__ unsigned xb_add(unsigned* p, unsigned v) { return __hip_atomic_fetch_add(p, v, __ATOMIC_RELAXED, __HIP_MEMORY_SCOPE_AGENT); }
__device__ __forceinline__ unsigned xb_xcc_id() { return (unsigned)__builtin_amdgcn_s_getreg((3 << 11) | 20) & 0xFu; }
#define XB_SPIN(cond, bar) do { unsigned _sp = 0; while (cond) { __builtin_amdgcn_s_sleep(1); \
    if ((++_sp & 255u) == 0u) { if (xb_ld(&(bar)[XB_TMO])) break; if (_sp > XB_SPIN_CAP) { atomicAdd(&(bar)[XB_TMO], 1u); break; } } } } while (0)
struct XcdBarrier { unsigned* bar; unsigned x; volatile LAS unsigned* st; };
__device__ __forceinline__ XcdBarrier xcd_barrier_post(unsigned* bar, volatile LAS unsigned* st) {
    XcdBarrier b; b.bar = bar; b.x = xb_xcc_id(); b.st = st;
    if (threadIdx.x == 0) (void)xb_add(&bar[XB_XCNT(b.x)], 1u);
    return b;
}
__device__ __forceinline__ void xcd_barrier_complete(unsigned* bar, unsigned x, unsigned& nloc, unsigned& nx) {
    const unsigned G = gridDim.x * gridDim.y * gridDim.z;
    unsigned sum, cnt, mine, sp = 0u;
    for (;;) {
        sum = 0u; cnt = 0u; mine = 0u;
#pragma unroll
        for (unsigned j = 0; j < 16; ++j) { const unsigned c = xb_ld(&bar[XB_XCNT(j)]); sum += c; cnt += (c > 0u) ? 1u : 0u; mine = (j == x) ? c : mine; }
        if (sum == G) break;
        __builtin_amdgcn_s_sleep(1);
        if ((++sp & 255u) == 0u) { if (xb_ld(&bar[XB_TMO])) break; if (sp > XB_SPIN_CAP) { atomicAdd(&bar[XB_TMO], 1u); break; } }
    }
    nloc = mine > 0u ? mine : 1u; nx = cnt > 0u ? cnt : 1u;
}
__device__ __forceinline__ void xcd_barrier(const XcdBarrier& b) {
    asm volatile("s_waitcnt vmcnt(0)" ::: "memory");
    __syncthreads();
    if (threadIdx.x == 0) {
        unsigned* bar = b.bar;
        __builtin_amdgcn_s_waitcnt(0);
        unsigned nloc = b.st[0], nx = b.st[1];
        if (nloc == 0u) { xcd_barrier_complete(bar, b.x, nloc, nx); b.st[0] = nloc; b.st[1] = nx; }
        const unsigned old = xb_add(&bar[XB_XSUB(b.x)], 1u);
        const unsigned gen = old / nloc;
        if (old + 1u == (gen + 1u) * nloc) {
            __builtin_amdgcn_fence(__ATOMIC_RELEASE, "agent");
            asm volatile("s_waitcnt vmcnt(0)" ::: "memory");
            const unsigned og = xb_add(&bar[XB_TOP], 1u);
            const unsigned tg = og / nx;
            if (og + 1u == (tg + 1u) * nx) xb_add(&bar[XB_TOPGEN], 1u);
            else XB_SPIN(xb_ld(&bar[XB_TOPGEN]) == tg, bar);
            __builtin_amdgcn_fence(__ATOMIC_ACQUIRE, "agent");
            xb_add(&bar[XB_XGEN(b.x)], 1u);
            asm volatile("s_waitcnt vmcnt(0)" ::: "memory");
        } else {
            XB_SPIN(xb_ld(&bar[XB_XGEN(b.x)]) == gen, bar);
            __builtin_amdgcn_fence(__ATOMIC_ACQUIRE, "agent");
            asm volatile("s_waitcnt vmcnt(0)" ::: "memory");
        }
    }
    __syncthreads();
}

constexpr int LDS_TOTAL = 147456;
__global__ void __launch_bounds__(512, 2) fwd_kernel(Params p) {
    extern __shared__ __attribute__((aligned(16))) unsigned char lds_raw[];
    cg::grid_group grid = cg::this_grid();
    Ctx C; C.lds = (LAS unsigned char*)lds_raw; C.tid = threadIdx.x; C.lane = C.tid & 63; C.wave = __builtin_amdgcn_readfirstlane(C.tid >> 6);
    C.G = gridDim.x; C.bid = blockIdx.x; C.gw = C.bid * 8 + C.wave; C.NGW = C.G * 8;
    unsigned char* ws = p.ws;
    const float* mod = (const float*)(ws + WS_MOD);
    float* XR = (float*)(ws + WS_XR); const bf16_t* XN = (const bf16_t*)(ws + WS_XN);
    const int lo = p.ph_lo, hi = p.ph_hi;
    volatile LAS unsigned* xst = (volatile LAS unsigned*)(C.lds + LDS_TOTAL - 64);
    if (C.tid < 2) xst[C.tid] = 0u;
    __syncthreads();
    XcdBarrier xbar = xcd_barrier_post((unsigned*)ws, xst);
    if (p.ph_hi > 1000) grid.sync();
#ifndef PH_MASK
#define PH_MASK 0xFFFFFFu
#endif
#define IN(k) ((((PH_MASK) >> (k)) & 1u) && lo <= (k) && (k) < hi)
#define RP(k) for (int rp_ = 0; rp_ < 1 + (int)(((REP_MASK) >> (k)) & 1u); ++rp_)
#define SEAM(k) do { if (IN(k) && IN((k) + 1)) { for (int br_ = 0; br_ < BAR_REP; ++br_) xcd_barrier(xbar); } } while (0)
#define GEMM_BF16(nM, nN, Ap, lda_, Bp, ldb_, Kk, Op, ldc_) do { pg8::GridSched S; S.init(nM, nN, C.G, C.bid, Ap, lda_, Bp, ldb_, Op, ldc_); S.rep = GREP; pg8::Gemm g{Kk, lda_, ldb_}; pg8::EpiBf16 E; \
        pg8::gemm_phase<pg8::EpiBf16, pg8::GridSched>(C.lds, g, S, E); } while (0)

    if (IN(0)) { phase_prologue(p, C); } SEAM(0);
    if (IN(1)) RP(1) { phase_normmod(p, C, p.in[0], p.in[2], 0, NTOK, p.in[6], 0, 0, 1, 0, nullptr, false); } SEAM(1);
    if (IN(2)) RP(2) { GEMM_BF16(33, 16, XN, DM, ws + WS_W0IN, DM, DM, (bf16_t*)(ws + WS_Z0), ABN);
                       tail_transposes(p, C, 0, 33 * 16); } SEAM(2);
    if (IN(3)) RP(3) { phase_mixprep0(p, C); } SEAM(3);
    if (IN(4)) RP(4) { GEMM_BF16(33, 6, ws + WS_QN, 512, ws + WS_W0QB, 512, 512, (bf16_t*)(ws + WS_Q), 1536);
                 GEMM_BF16(33, 8, ws + WS_KVN, 256, ws + WS_W0KVB, 256, 256, (bf16_t*)(ws + WS_KV), 2048); } SEAM(4);
    if (IN(5)) RP(5) { phase_attention(p, C, (char*)lds_raw); } SEAM(5);
    if (IN(6)) RP(6) { { pg8::GridSched S; S.init(32, 8, C.G, C.bid, ws + WS_OA, DM, ws + WS_W0OUT, DM, nullptr, 0); S.rep = P6REP; pg8::Gemm g{DM, DM, DM};
                   pg8::EpiResNorm E{p.in[0], XR, mod + 0 * NMOD + 2 * DM, p.in[14], mod + 0 * NMOD + 3 * DM, mod + 0 * NMOD + 4 * DM, (bf16_t*)(ws + WS_XN), nullptr, (float*)(ws + WS_SLOT) + (size_t)0 * 65536, (unsigned*)(ws + WS_CNT) + 0 * 2048, C.lds + pg8::STAGE_BYTES};
                   pg8::gemm_phase<pg8::EpiResNorm, pg8::GridSched>(C.lds, g, S, E); }
                 { pg8::MiniSched S{C.G, C.bid, 32, (const char*)(ws + WS_OA) + (size_t)SEQ * DM * 2, (const char*)(ws + WS_W0OUT), (size_t)256 * DM * 2}; pg8::Gemm g{512, DM, DM};
                   pg8::EpiPart E{(float*)(ws + WS_PART)};
                   pg8::gemm_phase<pg8::EpiPart, pg8::MiniSched>(C.lds, g, S, E); } } SEAM(6);
    if (IN(7)) RP(7) { phase_normmod(p, C, XR, p.in[2], SEQ, NTOK, p.in[14], 0, 3, 4, 4, mod + 1 * NMOD + 2 * DM, true); } SEAM(7);
    if (IN(8)) RP(8) { GEMM_BF16(33, 44, XN, DM, ws + WS_W0UP, DM, DM, (bf16_t*)(ws + WS_U), DFF2); tail_transposes(p, C, 1, 33 * 44); } SEAM(8);
    if (IN(9)) RP(9) { phase_convact(p, C, p.in[16], p.in[17], NTOK); } SEAM(9);
    if (IN(10)) RP(10) { { pg8::GridSched S; S.init(32, 8, C.G, C.bid, ws + WS_H, DFF, ws + WS_W0DN, DFF, nullptr, 0); pg8::Gemm g{DFF, DFF, DFF};
                    pg8::EpiResNorm E{XR, XR, mod + 0 * NMOD + 5 * DM, p.in[21], mod + 2 * NMOD + 0 * DM, mod + 2 * NMOD + 1 * DM, (bf16_t*)(ws + WS_XN), nullptr, (float*)(ws + WS_SLOT) + (size_t)1 * 65536, (unsigned*)(ws + WS_CNT) + 1 * 2048, C.lds + pg8::STAGE_BYTES};
                    pg8::gemm_phase<pg8::EpiResNorm, pg8::GridSched>(C.lds, g, S, E); }
                  { pg8::MiniSched S{C.G, C.bid, 88, (const char*)(ws + WS_H) + (size_t)SEQ * DFF * 2, (const char*)(ws + WS_W0DN), (size_t)256 * DFF * 2}; pg8::Gemm g{512, DFF, DFF};
                    pg8::EpiPart E{(float*)(ws + WS_PART)};
                    pg8::gemm_phase<pg8::EpiPart, pg8::MiniSched>(C.lds, g, S, E); } } SEAM(10);
    if (IN(11)) RP(11) { phase_normmod(p, C, XR, XR + (size_t)SEQ * DM, SEQ, NTOK, p.in[21], 1, 0, 1, 11, mod + 1 * NMOD + 5 * DM, false); } SEAM(11);
    if (IN(12)) RP(12) { GEMM_BF16(33, 25, XN, DM, ws + WS_W1IN, DM, DM, (bf16_t*)(ws + WS_Z1), GLN); tail_transposes(p, C, 2, 33 * 25); } SEAM(12);
    if (IN(13)) RP(13) { phase_gla_prep(p, C); } SEAM(13);
    if (IN(14)) RP(14) { { G2aSched S{C.G, C.bid, ws}; pg8::Gemm g{256, 768, 256}; pg8::EpiBf16 E; pg8::gemm_phase<pg8::EpiBf16, G2aSched>(C.lds, g, S, E); }
                  { G2bSched S{C.G, C.bid, ws}; pg8::Gemm g{256, 768, 256}; pg8::EpiBf16 E; pg8::gemm_phase<pg8::EpiBf16, G2bSched>(C.lds, g, S, E); } } SEAM(14);
    if (IN(15)) RP(15) { phase_gla_scan(p, C); } SEAM(15);
    if (IN(16)) RP(16) { G4Sched S{C.G, C.bid, ws}; pg8::Gemm g{768, 768, 768};
                  pg8::EpiGlaOut E{(const bf16_t*)(ws + WS_Z1), p.in[27], (bf16_t*)(ws + WS_O), (float*)(ws + WS_SLOT) + (size_t)4 * 65536, (unsigned*)(ws + WS_CNT) + 4 * 2048, C.lds + pg8::STAGE_BYTES};
                  pg8::gemm_phase<pg8::EpiGlaOut, G4Sched>(C.lds, g, S, E); } if (IN(16) && IN(18)) xcd_barrier(xbar);
    if (IN(18)) RP(18) { pg8::GridSched S; S.init(32, 8, C.G, C.bid, ws + WS_O, DM, ws + WS_W1OUT, DM, nullptr, 0); pg8::Gemm g{DM, DM, DM};
                  pg8::EpiResNorm E{XR, XR, mod + 2 * NMOD + 2 * DM, p.in[29], mod + 2 * NMOD + 3 * DM, mod + 2 * NMOD + 4 * DM, (bf16_t*)(ws + WS_XN), nullptr, (float*)(ws + WS_SLOT) + (size_t)2 * 65536, (unsigned*)(ws + WS_CNT) + 2 * 2048, C.lds + pg8::STAGE_BYTES};
                  pg8::gemm_phase<pg8::EpiResNorm, pg8::GridSched>(C.lds, g, S, E); } if (IN(18) && IN(20)) xcd_barrier(xbar);
    if (IN(20)) RP(20) { GEMM_BF16(32, 44, XN, DM, ws + WS_W1UP, DM, DM, (bf16_t*)(ws + WS_U), DFF2); } SEAM(20);
    if (IN(21)) RP(21) { phase_convact(p, C, p.in[31], p.in[32], SEQ); } SEAM(21);
    if (IN(22)) RP(22) { pg8::GridSched S; S.init(32, 8, C.G, C.bid, ws + WS_H, DFF, ws + WS_W1DN, DFF, nullptr, 0); pg8::Gemm g{DFF, DFF, DFF};
                  pg8::EpiResNorm E{XR, nullptr, mod + 2 * NMOD + 5 * DM, p.in[34], nullptr, nullptr, nullptr, p.out, (float*)(ws + WS_SLOT) + (size_t)3 * 65536, (unsigned*)(ws + WS_CNT) + 3 * 2048, C.lds + pg8::STAGE_BYTES};
                  pg8::gemm_phase<pg8::EpiResNorm, pg8::GridSched>(C.lds, g, S, E); }
#undef IN
#undef SEAM
}

extern "C" void kernel_launch(void* const* d_in, const int* in_sizes, int n_in, void* d_out, int out_size, void* d_ws, size_t ws_size, hipStream_t stream) {
    static int grid = 0;
    if (grid == 0) {
        if (n_in != 35 || ws_size < WS_END) { fprintf(stderr, "kernel_launch: unexpected n_in %d / ws_size %zu (need %zu)\n", n_in, ws_size, (size_t)WS_END); grid = -1; return; }
        int dev = 0, cus = 0, per_cu = 0;
        (void)hipGetDevice(&dev); (void)hipDeviceGetAttribute(&cus, hipDeviceAttributeMultiprocessorCount, dev);
        if (hipFuncSetAttribute((const void*)fwd_kernel, hipFuncAttributeMaxDynamicSharedMemorySize, LDS_TOTAL) != hipSuccess) { fprintf(stderr, "kernel_launch: hipFuncSetAttribute failed\n"); grid = -1; return; }
        (void)hipOccupancyMaxActiveBlocksPerMultiprocessor(&per_cu, (const void*)fwd_kernel, 512, LDS_TOTAL);
        if (per_cu < 1) { fprintf(stderr, "kernel_launch: occupancy query says %d blocks/CU\n", per_cu); per_cu = 1; }
        (void)hipGetLastError();
        grid = cus;
    }
    if (grid < 0) return;
    (void)hipMemsetAsync((char*)d_ws, 0, WS_MOD + 4 * NMOD * sizeof(float), stream);
    Params p{};
    for (int i = 0; i < 35; ++i) p.in[i] = (const float*)d_in[i];
    p.out = (float*)d_out; p.ws = (unsigned char*)d_ws;
#if N_LAUNCH_MODE == 1
    p.ph_lo = 0; p.ph_hi = NPHASE;
    void* args[] = {&p};
    hipError_t e = hipLaunchCooperativeKernel((const void*)fwd_kernel, dim3(grid), dim3(512), args, LDS_TOTAL, stream);
    if (e != hipSuccess) fprintf(stderr, "cooperative launch failed: %s (grid %d)\n", hipGetErrorString(e), grid);
#else
    for (int ph = 0; ph < NPHASE; ++ph) { p.ph_lo = ph; p.ph_hi = ph + 1; hipLaunchKernelGGL(fwd_kernel, dim3(grid), dim3(512), LDS_TOTAL, stream, p); }
#endif
}
```
